# Optimizing an MI355X kernel written in HIP

```python
import math
import jax, jax.numpy as jnp
from jax import lax
import numpy as np

D_MODEL = 2048
BATCH = 4
SEQ = 4096
DEPTH = 4

GRID_W = 64
CTX_LEN = 256
EPS = 1e-6
ROPE_THETA = 10000.0
N_MOD = 9
D_FF = 5632

SSD_HEADS = 16
SSD_HEADDIM = 64
SSD_INNER = SSD_HEADS * SSD_HEADDIM
SSD_GROUPS = 2
SSD_STATE = 128
SSD_CONV = 5
SSD_CHUNK = 128
SSD_CONV_CH = SSD_INNER + 2 * SSD_GROUPS * SSD_STATE
DT_MIN = 0.001
DT_MAX = 0.1

MLA_HEADS = 8
MLA_Q_RANK = 384
MLA_KV_RANK = 256
MLA_NOPE = 64
MLA_ROPE = 32
MLA_V = 64
MLA_BLOCK = 128

SWA_HEADS = 8
SWA_KV_HEADS = 2
SWA_HEADDIM = 64
SWA_WINDOW = 128
SWA_BLOCK = 128

D_MIX = SSD_INNER + MLA_HEADS * MLA_V + SWA_HEADS * SWA_HEADDIM
IN_SIZES = (SSD_INNER, SSD_CONV_CH, 2 * SSD_HEADS, MLA_Q_RANK, MLA_KV_RANK, MLA_ROPE,
            SWA_HEADS * SWA_HEADDIM, SWA_KV_HEADS * SWA_HEADDIM, SWA_KV_HEADS * SWA_HEADDIM)
D_IN = (SSD_INNER + SSD_CONV_CH + 2 * SSD_HEADS + MLA_Q_RANK + MLA_KV_RANK + MLA_ROPE
        + SWA_HEADS * SWA_HEADDIM + 2 * SWA_KV_HEADS * SWA_HEADDIM)

kernel_name = "hybrid_parallel_group_diffusion_trunk"


def rms_norm(x, g):
    xf = x.astype(jnp.float32)
    y = xf * lax.rsqrt(jnp.mean(xf * xf, axis=-1, keepdims=True) + EPS)
    return (y * g.astype(jnp.float32)).astype(x.dtype)


def modulate(u, shift, scale):
    return u * (1 + scale) + shift


def swiglu(u, wg, wu, wd):
    return (jax.nn.silu(u @ wg) * (u @ wu)) @ wd


def split_cols(p):
    offs = np.cumsum(IN_SIZES)[:-1].tolist()
    return jnp.split(p, offs, axis=-1)


def axial_rope_tables(pos_row, pos_col, dim):
    quarter = dim // 4
    inv_freq = ROPE_THETA ** (-jnp.arange(quarter, dtype=jnp.float32) / quarter)
    ang_r = pos_row.astype(jnp.float32)[:, None] * inv_freq[None, :]
    ang_c = pos_col.astype(jnp.float32)[:, None] * inv_freq[None, :]
    ang = jnp.concatenate([ang_r, ang_r, ang_c, ang_c], axis=-1)
    return jnp.cos(ang), jnp.sin(ang)


def _rotate_half(v):
    a, b = jnp.split(v, 2, axis=-1)
    return jnp.concatenate([-b, a], axis=-1)


def apply_axial_rope(x, cos, sin):
    xr, xc = jnp.split(x, 2, axis=-1)
    rot = jnp.concatenate([_rotate_half(xr), _rotate_half(xc)], axis=-1)
    return x * cos[None, :, None, :].astype(x.dtype) + rot * sin[None, :, None, :].astype(x.dtype)


def dwconv_centred(x, w, b):
    y = lax.conv_general_dilated(
        x, w[:, None, :].astype(x.dtype), window_strides=(1,),
        padding=[(SSD_CONV // 2, SSD_CONV // 2)],
        dimension_numbers=("NWC", "WIO", "NWC"), feature_group_count=x.shape[-1])
    return y + b.astype(x.dtype)


def ssd_chunk_terms(xs, dt, A, Bm):
    b, l, h, pdim = xs.shape
    g, n = Bm.shape[2], Bm.shape[3]
    r, nc = h // g, l // SSD_CHUNK
    xdt = (xs * dt[..., None]).reshape(b, nc, SSD_CHUNK, g, r, pdim)
    a_cum = jnp.cumsum((dt * A).reshape(b, nc, SSD_CHUNK, g, r), axis=2)
    Bc = Bm.reshape(b, nc, SSD_CHUNK, g, n)
    return xdt, a_cum, Bc


def ssd_chunk_states(xdt, a_cum, Bc, h0):
    decay_to_end = jnp.exp(a_cum[:, :, -1:] - a_cum).astype(xdt.dtype)
    s_local = jnp.einsum('bcsgn,bcsgr,bcsgrp->bcgrpn', Bc, decay_to_end, xdt).astype(jnp.float32)
    chunk_decay = jnp.exp(a_cum[:, :, -1])

    def step(h, inp):
        s, dec = inp
        return dec[..., None, None] * h + s, h

    h_final, h_in = lax.scan(step, h0, (jnp.moveaxis(s_local, 1, 0), jnp.moveaxis(chunk_decay, 1, 0)))
    return jnp.moveaxis(h_in, 0, 1), h_final


def ssd_chunk_outputs(xdt, a_cum, Bc, Cm, h_in):
    b, nc, q, g, r, pdim = xdt.shape
    Cc = Cm.reshape(b, nc, q, g, -1)
    seg = a_cum[:, :, :, None] - a_cum[:, :, None, :]
    lower_tri = jnp.tril(jnp.ones((q, q), bool))[None, None, :, :, None, None]
    decay = jnp.exp(jnp.where(lower_tri, seg, -jnp.inf)).astype(xdt.dtype)
    cb = jnp.einsum('bclgn,bcsgn->bclsg', Cc, Bc)
    y_diag = jnp.einsum('bclsg,bclsgr,bcsgrp->bclgrp', cb, decay, xdt)
    y_off = jnp.einsum('bclgn,bclgr,bcgrpn->bclgrp', Cc, jnp.exp(a_cum).astype(xdt.dtype),
                       h_in.astype(xdt.dtype))
    return (y_diag + y_off).reshape(b, nc * q, g * r, pdim)


def ssd_scan(xs, dt, A, Bm, Cm, h0):
    xdt, a_cum, Bc = ssd_chunk_terms(xs, dt, A, Bm)
    h_in, _ = ssd_chunk_states(xdt, a_cum, Bc, h0)
    return ssd_chunk_outputs(xdt, a_cum, Bc, Cm, h_in)


def _orient(t, d):
    return t if d == 0 else jnp.flip(t, axis=1)


def _ssd_inputs(xbc, dt_raw, p):
    b, l = xbc.shape[:2]
    xbc = jax.nn.silu(dwconv_centred(xbc, p['conv_w'], p['conv_b']))
    xs, Bm, Cm = jnp.split(xbc, [SSD_INNER, SSD_INNER + SSD_GROUPS * SSD_STATE], axis=-1)
    xs = xs.reshape(b, l, SSD_HEADS, SSD_HEADDIM)
    Bm = Bm.reshape(b, l, SSD_GROUPS, SSD_STATE)
    Cm = Cm.reshape(b, l, SSD_GROUPS, SSD_STATE)
    dt = jax.nn.softplus(dt_raw.reshape(b, l, 2, SSD_HEADS).astype(jnp.float32)
                         + p['dt_bias'].astype(jnp.float32))
    return xs, dt, Bm, Cm


def _ssd_finish(y_dirs, xs, z, p):
    b, l = xs.shape[:2]
    y = y_dirs[0] + y_dirs[1] + p['d_skip'][:, None].astype(xs.dtype) * xs
    y = y.reshape(b, l, SSD_INNER) * jax.nn.silu(z)
    y = rms_norm(y.reshape(b, l, SSD_GROUPS, SSD_INNER // SSD_GROUPS),
                 p['ssd_norm'].reshape(SSD_GROUPS, SSD_INNER // SSD_GROUPS))
    return y.reshape(b, l, SSD_INNER)


def ssd_group(zx, xbcx, dtx, zc, xbcc, dtc, p, ctx_out):
    A = -jnp.exp(p['a_log'].astype(jnp.float32))
    xs_x, dt_x, B_x, C_x = _ssd_inputs(xbcx, dtx, p)
    xs_c, dt_c, B_c, C_c = _ssd_inputs(xbcc, dtc, p)
    b = xs_c.shape[0]
    h0 = jnp.zeros((b, SSD_GROUPS, SSD_HEADS // SSD_GROUPS, SSD_HEADDIM, SSD_STATE), jnp.float32)
    y_x, y_c = [], []
    for d in range(2):
        terms = ssd_chunk_terms(_orient(xs_c, d), _orient(dt_c[:, :, d], d), A[d], _orient(B_c, d))
        h_in_c, h_ctx = ssd_chunk_states(*terms, h0)
        if ctx_out:
            y_c.append(_orient(ssd_chunk_outputs(*terms, _orient(C_c, d), h_in_c), d))
        y = ssd_scan(_orient(xs_x, d), _orient(dt_x[:, :, d], d), A[d], _orient(B_x, d),
                     _orient(C_x, d), h_ctx)
        y_x.append(_orient(y, d))
    out_x = _ssd_finish(y_x, xs_x, zx, p)
    out_c = _ssd_finish(y_c, xs_c, zc, p) if ctx_out else None
    return out_x, out_c


def mla_qkv(cq, ckv, kr, p, rope):
    b, l = cq.shape[:2]
    q = (rms_norm(cq, p['q_norm']) @ p['w_uq']).reshape(b, l, MLA_HEADS, MLA_NOPE + MLA_ROPE)
    kv = (rms_norm(ckv, p['kv_norm']) @ p['w_ukv']).reshape(b, l, MLA_HEADS, MLA_NOPE + MLA_V)
    q_nope, q_rope = jnp.split(q, [MLA_NOPE], axis=-1)
    k_nope, v = jnp.split(kv, [MLA_NOPE], axis=-1)
    k_rope = kr[:, :, None, :]
    if rope is not None:
        q_rope = apply_axial_rope(q_rope, *rope)
        k_rope = apply_axial_rope(k_rope, *rope)
    q = jnp.concatenate([q_nope, q_rope], axis=-1)
    k = jnp.concatenate([k_nope, jnp.broadcast_to(k_rope, (b, l, MLA_HEADS, MLA_ROPE))], axis=-1)
    return q, k, v


def dense_attention_blocks(q, k, v):
    b, L, h, d = q.shape
    n = L // MLA_BLOCK
    scale = d ** -0.5
    qb = jnp.moveaxis(q.reshape(b, n, MLA_BLOCK, h, d), 1, 0)

    def one_block(qblk):
        s = jnp.einsum('bqhd,bkhd->bhqk', qblk, k).astype(jnp.float32) * scale
        pr = jax.nn.softmax(s, axis=-1).astype(v.dtype)
        return jnp.einsum('bhqk,bkhd->bqhd', pr, v)

    o = lax.map(one_block, qb)
    return jnp.moveaxis(o, 0, 1).reshape(b, L, h * v.shape[-1])


def swa_latent(q, k, v, kc, vc, sink):
    b, L, H, d = q.shape
    G = SWA_KV_HEADS
    r, W, n, Cn = H // G, SWA_BLOCK, L // SWA_BLOCK, kc.shape[1]
    scale = d ** -0.5
    qb = q.reshape(b, n, W, G, r, d)
    pad = ((0, 0), (W, W), (0, 0), (0, 0))
    kp = jnp.pad(k, pad).reshape(b, n + 2, W, G, d)
    vp = jnp.pad(v, pad).reshape(b, n + 2, W, G, d)
    kwin = jnp.concatenate([kp[:, :-2], kp[:, 1:-1], kp[:, 2:]], axis=2)
    vwin = jnp.concatenate([vp[:, :-2], vp[:, 1:-1], vp[:, 2:]], axis=2)
    qi = jnp.arange(W)
    kj = jnp.arange(3 * W)
    rel = kj[None, :] - W - qi[:, None]
    key_pos = jnp.arange(n)[:, None] * W - W + kj[None, :]
    mask = (jnp.abs(rel) <= SWA_WINDOW)[None] & ((key_pos >= 0) & (key_pos < L))[:, None, :]
    s_loc = jnp.einsum('bnqgrd,bnkgd->bngrqk', qb, kwin).astype(jnp.float32) * scale
    s_loc = jnp.where(mask[None, :, None, None], s_loc, -jnp.inf)
    s_ctx = jnp.einsum('bnqgrd,bcgd->bngrqc', qb, kc).astype(jnp.float32) * scale
    s_sink = jnp.broadcast_to(sink.reshape(G, r)[None, None, :, :, None, None].astype(jnp.float32),
                              s_ctx.shape[:-1] + (1,))
    pr = jax.nn.softmax(jnp.concatenate([s_ctx, s_loc, s_sink], axis=-1), axis=-1).astype(v.dtype)
    p_ctx, p_loc = pr[..., :Cn], pr[..., Cn:Cn + 3 * W]
    o = (jnp.einsum('bngrqc,bcgd->bnqgrd', p_ctx, vc)
         + jnp.einsum('bngrqk,bnkgd->bnqgrd', p_loc, vwin))
    return o.reshape(b, L, H * d)


def sink_attention_ctx(q, k, v, sink):
    b, Cn, H, d = q.shape
    G = k.shape[2]
    r = H // G
    qg = q.reshape(b, Cn, G, r, d)
    s = jnp.einsum('bqgrd,bkgd->bgrqk', qg, k).astype(jnp.float32) * (d ** -0.5)
    s_sink = jnp.broadcast_to(sink.reshape(G, r)[None, :, :, None, None].astype(jnp.float32),
                              s.shape[:-1] + (1,))
    pr = jax.nn.softmax(jnp.concatenate([s, s_sink], axis=-1), axis=-1)[..., :-1].astype(v.dtype)
    return jnp.einsum('bgrqk,bkgd->bqgrd', pr, v).reshape(b, Cn, H * d)


def head_group_mixing(ux, uc, p, rope_mla, rope_swa, ctx_out):
    b, L = ux.shape[:2]
    Cn = uc.shape[1]
    zx, xbcx, dtx, cqx, ckvx, krx, qsx, ksx, vsx = split_cols(ux @ p['w_in'])
    zc, xbcc, dtc, cqc, ckvc, krc, qsc, ksc, vsc = split_cols(uc @ p['w_in'])
    ssd_x, ssd_c = ssd_group(zx, xbcx, dtx, zc, xbcc, dtc, p, ctx_out)
    q_mx, k_mx, v_mx = mla_qkv(cqx, ckvx, krx, p, rope_mla)
    q_mc, k_mc, v_mc = mla_qkv(cqc, ckvc, krc, p, None)
    k_all = jnp.concatenate([k_mx, k_mc], axis=1)
    v_all = jnp.concatenate([v_mx, v_mc], axis=1)
    mla_x = dense_attention_blocks(q_mx, k_all, v_all)
    q_sx = apply_axial_rope(qsx.reshape(b, L, SWA_HEADS, SWA_HEADDIM), *rope_swa)
    k_sx = apply_axial_rope(ksx.reshape(b, L, SWA_KV_HEADS, SWA_HEADDIM), *rope_swa)
    v_sx = vsx.reshape(b, L, SWA_KV_HEADS, SWA_HEADDIM)
    k_sc = ksc.reshape(b, Cn, SWA_KV_HEADS, SWA_HEADDIM)
    v_sc = vsc.reshape(b, Cn, SWA_KV_HEADS, SWA_HEADDIM)
    swa_x = swa_latent(q_sx, k_sx, v_sx, k_sc, v_sc, p['sink'])
    ox = jnp.concatenate([ssd_x, rms_norm(mla_x, p['mla_out_norm']),
                          rms_norm(swa_x, p['swa_out_norm'])], axis=-1)
    if not ctx_out:
        return ox, None
    mla_c = dense_attention_blocks(q_mc, k_mc, v_mc)
    swa_c = sink_attention_ctx(qsc.reshape(b, Cn, SWA_HEADS, SWA_HEADDIM), k_sc, v_sc, p['sink'])
    oc = jnp.concatenate([ssd_c, rms_norm(mla_c, p['mla_out_norm']),
                          rms_norm(swa_c, p['swa_out_norm'])], axis=-1)
    return ox, oc


def setup_inputs(seed: int = 0) -> dict:
    key = jax.random.key(seed)
    ks = jax.random.split(key, 32)
    f32 = jnp.float32

    def nrm(k, shape, scale):
        return jax.random.normal(k, shape, f32) * scale

    def gain(k, shape):
        return 1.0 + 0.05 * jax.random.normal(k, shape, f32)

    u = jax.random.uniform(ks[14], (DEPTH, 2, SSD_HEADS), f32)
    dt0 = jnp.exp(u * (math.log(DT_MAX) - math.log(DT_MIN)) + math.log(DT_MIN))
    return {
        "x": nrm(ks[0], (BATCH, SEQ, D_MODEL), 1.0),
        "c": nrm(ks[1], (BATCH, D_MODEL), 1.0),
        "ctx": nrm(ks[2], (BATCH, CTX_LEN, D_MODEL), 1.0),
        "c_ctx": nrm(ks[3], (D_MODEL,), 1.0),
        "w_mod": nrm(ks[4], (DEPTH, D_MODEL, N_MOD * D_MODEL), 0.5 * D_MODEL ** -0.5),
        "b_mod": nrm(ks[5], (DEPTH, N_MOD * D_MODEL), 0.02),
        "norm_g": gain(ks[6], (DEPTH, 3, D_MODEL)),
        "ffn_w_gate": nrm(ks[7], (DEPTH, 2, D_MODEL, D_FF), D_MODEL ** -0.5),
        "ffn_w_up": nrm(ks[8], (DEPTH, 2, D_MODEL, D_FF), D_MODEL ** -0.5),
        "ffn_w_down": nrm(ks[9], (DEPTH, 2, D_FF, D_MODEL), D_FF ** -0.5),
        "w_in": nrm(ks[10], (DEPTH, D_MODEL, D_IN), D_MODEL ** -0.5),
        "w_out": nrm(ks[11], (DEPTH, D_MIX, D_MODEL), D_MIX ** -0.5),
        "ssd_conv_w": nrm(ks[12], (DEPTH, SSD_CONV, SSD_CONV_CH), SSD_CONV ** -0.5),
        "ssd_conv_b": nrm(ks[13], (DEPTH, SSD_CONV_CH), 0.02),
        "ssd_dt_bias": dt0 + jnp.log(-jnp.expm1(-dt0)),
        "ssd_a_log": jnp.log(jax.random.uniform(ks[15], (DEPTH, 2, SSD_HEADS), f32, 1.0, 16.0)),
        "ssd_d": 1.0 + 0.1 * jax.random.normal(ks[16], (DEPTH, SSD_HEADS), f32),
        "ssd_norm": gain(ks[17], (DEPTH, SSD_INNER)),
        "mla_q_norm": gain(ks[18], (DEPTH, MLA_Q_RANK)),
        "mla_w_uq": nrm(ks[19], (DEPTH, MLA_Q_RANK, MLA_HEADS * (MLA_NOPE + MLA_ROPE)), MLA_Q_RANK ** -0.5),
        "mla_kv_norm": gain(ks[20], (DEPTH, MLA_KV_RANK)),
        "mla_w_ukv": nrm(ks[21], (DEPTH, MLA_KV_RANK, MLA_HEADS * (MLA_NOPE + MLA_V)), MLA_KV_RANK ** -0.5),
        "mla_out_norm": gain(ks[22], (DEPTH, MLA_HEADS * MLA_V)),
        "swa_sink": nrm(ks[23], (DEPTH, SWA_HEADS), 0.5),
        "swa_out_norm": gain(ks[24], (DEPTH, SWA_HEADS * SWA_HEADDIM)),
        "final_norm": gain(ks[25], (D_MODEL,)),
    }


def reference(x, c, ctx, c_ctx, w_mod, b_mod, norm_g, ffn_w_gate, ffn_w_up, ffn_w_down,
              w_in, w_out, ssd_conv_w, ssd_conv_b, ssd_dt_bias, ssd_a_log, ssd_d, ssd_norm,
              mla_q_norm, mla_w_uq, mla_kv_norm, mla_w_ukv, mla_out_norm, swa_sink,
              swa_out_norm, final_norm):
    L = x.shape[1]
    ROWS = L // GRID_W
    pos_row = jnp.repeat(jnp.arange(ROWS, dtype=jnp.int32), GRID_W)
    pos_col = jnp.tile(jnp.arange(GRID_W, dtype=jnp.int32), ROWS)
    rope_mla = axial_rope_tables(pos_row, pos_col, MLA_ROPE)
    rope_swa = axial_rope_tables(pos_row, pos_col, SWA_HEADDIM)

    hx, hc = x, ctx
    for l in range(DEPTH):
        last = l == DEPTH - 1
        mod_x = jnp.split((jax.nn.silu(c) @ w_mod[l] + b_mod[l])[:, None, :], N_MOD, axis=-1)
        mod_c = jnp.split((jax.nn.silu(c_ctx) @ w_mod[l] + b_mod[l])[None, None, :], N_MOD, axis=-1)
        hx = hx + 0.5 * mod_x[2] * swiglu(modulate(rms_norm(hx, norm_g[l, 0]), mod_x[0], mod_x[1]),
                                          ffn_w_gate[l, 0], ffn_w_up[l, 0], ffn_w_down[l, 0])
        hc = hc + 0.5 * mod_c[2] * swiglu(modulate(rms_norm(hc, norm_g[l, 0]), mod_c[0], mod_c[1]),
                                          ffn_w_gate[l, 0], ffn_w_up[l, 0], ffn_w_down[l, 0])
        p = {"w_in": w_in[l], "conv_w": ssd_conv_w[l], "conv_b": ssd_conv_b[l],
             "dt_bias": ssd_dt_bias[l], "a_log": ssd_a_log[l], "d_skip": ssd_d[l],
             "ssd_norm": ssd_norm[l], "q_norm": mla_q_norm[l], "w_uq": mla_w_uq[l],
             "kv_norm": mla_kv_norm[l], "w_ukv": mla_w_ukv[l], "mla_out_norm": mla_out_norm[l],
             "sink": swa_sink[l], "swa_out_norm": swa_out_norm[l]}
        ux = modulate(rms_norm(hx, norm_g[l, 1]), mod_x[3], mod_x[4])
        uc = modulate(rms_norm(hc, norm_g[l, 1]), mod_c[3], mod_c[4])
        ox, oc = head_group_mixing(ux, uc, p, rope_mla, rope_swa, not last)
        hx = hx + mod_x[5] * (ox @ w_out[l])
        hx = hx + 0.5 * mod_x[8] * swiglu(modulate(rms_norm(hx, norm_g[l, 2]), mod_x[6], mod_x[7]),
                                          ffn_w_gate[l, 1], ffn_w_up[l, 1], ffn_w_down[l, 1])
        if not last:
            hc = hc + mod_c[5] * (oc @ w_out[l])
            hc = hc + 0.5 * mod_c[8] * swiglu(modulate(rms_norm(hc, norm_g[l, 2]), mod_c[6], mod_c[7]),
                                              ffn_w_gate[l, 1], ffn_w_up[l, 1], ffn_w_down[l, 1])
    return rms_norm(hx, final_norm)
```

```cpp
#include <hip/hip_runtime.h>
#include <cstdio>
#include <cstdint>

#define GAS __attribute__((address_space(1)))
#define LAS __attribute__((address_space(3)))
typedef unsigned short bf16;
typedef short bf16x8 __attribute__((ext_vector_type(8)));
typedef float f32x4 __attribute__((ext_vector_type(4)));
typedef float f32x2 __attribute__((ext_vector_type(2)));
typedef unsigned u32x4 __attribute__((ext_vector_type(4)));
typedef unsigned u32x2 __attribute__((ext_vector_type(2)));

#ifndef ONE_LAUNCH
#define ONE_LAUNCH 1
#define PROBE_SET 0
#define PROBE_SUB 0
#endif

constexpr int D = 2048, NB = 4, SEQ = 4096, DEPTH = 4, CTX = 256, DFF = 5632, NMODV = 9 * 2048;
constexpr int ML = NB * SEQ, MC = NB * CTX, MT = ML + MC;
constexpr int DIN = 4032, DINP = 4096;
constexpr int PC_Z = 0, PC_XBC = 1024, PC_DT = 2560, PC_CQ = 2592, PC_CKV = 2976, PC_KR = 3232, PC_QS = 3264, PC_KS = 3776, PC_VS = 3904;
constexpr float EPS = 1e-6f;
constexpr float LOG2E = 1.4426950408889634f;

constexpr size_t MiB = 1u << 20;
constexpr size_t WS_CTL = 0, CTL_ZERO_BYTES = 64 * 1024;
constexpr size_t WS_MODP = 1 * MiB;
constexpr size_t WS_MODV = 13 * MiB;
constexpr size_t WS_WGU = 16 * MiB;
constexpr size_t WS_WD = 368 * MiB;
constexpr size_t WS_WIN = 544 * MiB;
constexpr size_t WS_WOUT = 608 * MiB;
constexpr size_t WS_WUQ = 640 * MiB;
constexpr size_t WS_WUK = 643 * MiB;
constexpr size_t WS_WUV = 644 * MiB;
constexpr size_t WS_RSTD = 645 * MiB;
constexpr size_t WS_DT = 646 * MiB;
constexpr size_t WS_H = 652 * MiB;
constexpr size_t WS_U = 788 * MiB;
constexpr size_t WS_OX = 856 * MiB;
constexpr size_t WS_P = 924 * MiB;
constexpr size_t WS_HID = 1060 * MiB;
constexpr size_t WS_XS = 1247 * MiB;
constexpr size_t WS_BC = 1281 * MiB;
constexpr size_t WS_QM = 1298 * MiB;
constexpr size_t WS_KM = 1324 * MiB;
constexpr size_t WS_VT = 1350 * MiB;
constexpr size_t WS_KS = 1367 * MiB;
constexpr size_t WS_VST = 1372 * MiB;
constexpr size_t WS_MX = 1377 * MiB;
constexpr size_t WS_SX = 1411 * MiB;
constexpr size_t WS_ST = 1445 * MiB;
constexpr size_t WS_BT = 1513 * MiB;
constexpr size_t WS_CB = 1522 * MiB;
constexpr size_t WS_CUM = 1531 * MiB;
constexpr size_t WS_DEC = 1536 * MiB;
constexpr size_t WS_YG = 1537 * MiB;
constexpr size_t WS_SSQ = 1571 * MiB;
constexpr size_t WS_PART = 1573 * MiB;
constexpr size_t WS_END = 1637 * MiB;
constexpr int CW_BAR = 4096;

constexpr int RING_BYTES = 131072;
constexpr int LDSCTL_OFF = RING_BYTES, MISC_OFF = LDSCTL_OFF + 320;
constexpr int LDS_BYTES = 147456;
constexpr int NWAVES = 8;

#define RLX_AGENT __ATOMIC_RELAXED, __HIP_MEMORY_SCOPE_AGENT
#define LDS_WAIT() asm volatile("s_waitcnt lgkmcnt(0)" ::: "memory")
#define VM_WAIT() asm volatile("s_waitcnt vmcnt(0)" ::: "memory")

typedef __bf16 bf16x2_t __attribute__((ext_vector_type(2)));
__device__ __forceinline__ unsigned pk2(float lo, float hi) { const f32x2 v = {lo, hi}; return __builtin_bit_cast(unsigned, __builtin_convertvector(v, bf16x2_t)); }
__device__ __forceinline__ unsigned f2bf(float f) { return pk2(f, 0.f) & 0xffffu; }
__device__ __forceinline__ float bf2f(bf16 b) { return __builtin_bit_cast(float, (unsigned)b << 16); }
__device__ __forceinline__ float bflo(unsigned w) { return __builtin_bit_cast(float, w << 16); }
__device__ __forceinline__ float bfhi(unsigned w) { return __builtin_bit_cast(float, w & 0xffff0000u); }
__device__ __forceinline__ float wave_sum(float v) {
#pragma unroll
    for (int o = 1; o < 64; o <<= 1) v += __shfl_xor(v, o);
    return v;
}
__device__ __forceinline__ float wave_max(float v) {
#pragma unroll
    for (int o = 1; o < 64; o <<= 1) v = fmaxf(v, __shfl_xor(v, o));
    return v;
}
__device__ __forceinline__ float silu_f(float x) { return x / (1.f + __expf(-x)); }

__device__ const float ROPE_COS_8[512] = { 1.00000000e+00f, 1.00000000e+00f, 1.00000000e+00f, 1.00000000e+00f, 1.00000000e+00f, 1.00000000e+00f, 1.00000000e+00f, 1.00000000e+00f, 5.40302277e-01f, 9.50415254e-01f, 9.95004177e-01f, 9.99500036e-01f, 9.99949992e-01f, 9.99994993e-01f, 9.99999523e-01f, 9.99999940e-01f, -4.16146845e-01f, 8.06578398e-01f, 9.80066597e-01f, 9.98000681e-01f, 9.99800026e-01f, 9.99979973e-01f, 9.99997973e-01f, 9.99999821e-01f, -9.89992499e-01f, 5.82753658e-01f, 9.55336511e-01f, 9.95503366e-01f, 9.99550045e-01f, 9.99954998e-01f, 9.99995530e-01f, 9.99999523e-01f, -6.53643608e-01f, 3.01137477e-01f, 9.21060979e-01f, 9.92010653e-01f, 9.99200106e-01f, 9.99920011e-01f, 9.99992013e-01f, 9.99999225e-01f, 2.83662200e-01f, -1.03423381e-02f, 8.77582550e-01f, 9.87526000e-01f, 9.98750269e-01f, 9.99875009e-01f, 9.99987483e-01f, 9.99998748e-01f, 9.60170269e-01f, -3.20796400e-01f, 8.25335622e-01f, 9.82053936e-01f, 9.98200536e-01f, 9.99819994e-01f, 9.99981999e-01f, 9.99998212e-01f, 7.53902256e-01f, -5.99437475e-01f, 7.64842212e-01f, 9.75599885e-01f, 9.97551024e-01f, 9.99755025e-01f, 9.99975502e-01f, 9.99997556e-01f, -1.45500034e-01f, -8.18632424e-01f, 6.96706712e-01f, 9.68170285e-01f, 9.96801734e-01f, 9.99680042e-01f, 9.99967992e-01f, 9.99996781e-01f, -9.11130250e-01f, -9.56644177e-01f, 6.21609926e-01f, 9.59772646e-01f, 9.95952725e-01f, 9.99595046e-01f, 9.99959528e-01f, 9.99995947e-01f, -8.39071512e-01f, -9.99786079e-01f, 5.40302277e-01f, 9.50415313e-01f, 9.95004177e-01f, 9.99500036e-01f, 9.99949992e-01f, 9.99994993e-01f, 4.42569796e-03f, -9.43779767e-01f, 4.53596085e-01f, 9.40107584e-01f, 9.93956089e-01f, 9.99395072e-01f, 9.99939501e-01f, 9.99993920e-01f, 8.43853951e-01f, -7.94179380e-01f, 3.62357706e-01f, 9.28859890e-01f, 9.92808640e-01f, 9.99280095e-01f, 9.99927998e-01f, 9.99992788e-01f, 9.07446802e-01f, -5.65820515e-01f, 2.67498761e-01f, 9.16683376e-01f, 9.91561890e-01f, 9.99155104e-01f, 9.99915481e-01f, 9.99991536e-01f, 1.36737213e-01f, -2.81349480e-01f, 1.69967160e-01f, 9.03590262e-01f, 9.90216017e-01f, 9.99020159e-01f, 9.99902010e-01f, 9.99990225e-01f, -7.59687901e-01f, 3.10223512e-02f, 7.07371980e-02f, 8.89593601e-01f, 9.88771081e-01f, 9.98875201e-01f, 9.99887526e-01f, 9.99988735e-01f, -9.57659483e-01f, 3.40318173e-01f, -2.91995462e-02f, 8.74707460e-01f, 9.87227261e-01f, 9.98720288e-01f, 9.99872029e-01f, 9.99987185e-01f, -2.75163352e-01f, 6.15864813e-01f, -1.28844544e-01f, 8.58946681e-01f, 9.85584795e-01f, 9.98555362e-01f, 9.99855518e-01f, 9.99985576e-01f, 6.60316706e-01f, 8.30336154e-01f, -2.27202162e-01f, 8.42327058e-01f, 9.83843684e-01f, 9.98380423e-01f, 9.99837995e-01f, 9.99983788e-01f, 9.88704622e-01f, 9.62463796e-01f, -3.23289543e-01f, 8.24865162e-01f, 9.82004225e-01f, 9.98195529e-01f, 9.99819517e-01f, 9.99981940e-01f, 4.08082068e-01f, 9.99144375e-01f, -4.16146845e-01f, 8.06578457e-01f, 9.80066597e-01f, 9.98000681e-01f, 9.99800026e-01f, 9.99979973e-01f, -5.47729254e-01f, 9.36740458e-01f, -5.04846215e-01f, 7.87485182e-01f, 9.78030920e-01f, 9.97795820e-01f, 9.99779522e-01f, 9.99977946e-01f, -9.99960840e-01f, 7.81440377e-01f, -5.88501155e-01f, 7.67604589e-01f, 9.75897431e-01f, 9.97581005e-01f, 9.99758005e-01f, 9.99975801e-01f, -5.32833040e-01f, 5.48645258e-01f, -6.66275978e-01f, 7.46956408e-01f, 9.73666370e-01f, 9.97356176e-01f, 9.99735534e-01f, 9.99973536e-01f, 4.24179018e-01f, 2.61441678e-01f, -7.37393796e-01f, 7.25561321e-01f, 9.71337974e-01f, 9.97121394e-01f, 9.99711990e-01f, 9.99971211e-01f, 9.91202831e-01f, -5.16893305e-02f, -8.01143587e-01f, 7.03440726e-01f, 9.68912423e-01f, 9.96876657e-01f, 9.99687493e-01f, 9.99968767e-01f, 6.46919310e-01f, -3.59694332e-01f, -8.56888831e-01f, 6.80616796e-01f, 9.66389954e-01f, 9.96621907e-01f, 9.99662042e-01f, 9.99966204e-01f, -2.92138815e-01f, -6.32028639e-01f, -9.04072165e-01f, 6.57112300e-01f, 9.63770926e-01f, 9.96357203e-01f, 9.99635518e-01f, 9.99963522e-01f, -9.62605894e-01f, -8.41684937e-01f, -9.42222297e-01f, 6.32950664e-01f, 9.61055458e-01f, 9.96082544e-01f, 9.99608040e-01f, 9.99960780e-01f, -7.48057544e-01f, -9.67871487e-01f, -9.70958173e-01f, 6.08156204e-01f, 9.58243906e-01f, 9.95797932e-01f, 9.99579549e-01f, 9.99957979e-01f, 1.54251456e-01f, -9.98075247e-01f, -9.89992499e-01f, 5.82753658e-01f, 9.55336511e-01f, 9.95503366e-01f, 9.99550045e-01f, 9.99954998e-01f, 9.14742351e-01f, -9.29300308e-01f, -9.99135137e-01f, 5.56768358e-01f, 9.52333570e-01f, 9.95198846e-01f, 9.99519527e-01f, 9.99951959e-01f, 8.34223390e-01f, -7.68367112e-01f, -9.98294771e-01f, 5.30226350e-01f, 9.49235439e-01f, 9.94884372e-01f, 9.99488056e-01f, 9.99948800e-01f, -1.32767474e-02f, -5.31235278e-01f, -9.87479806e-01f, 5.03154159e-01f, 9.46042359e-01f, 9.94559944e-01f, 9.99455571e-01f, 9.99945521e-01f, -8.48570287e-01f, -2.41421118e-01f, -9.66798186e-01f, 4.75578904e-01f, 9.42754686e-01f, 9.94225562e-01f, 9.99422073e-01f, 9.99942183e-01f, -9.03692186e-01f, 7.23346695e-02f, -9.36456680e-01f, 4.47528064e-01f, 9.39372718e-01f, 9.93881226e-01f, 9.99387562e-01f, 9.99938726e-01f, -1.27963692e-01f, 3.78916174e-01f, -8.96758378e-01f, 4.19029742e-01f, 9.35896814e-01f, 9.93526995e-01f, 9.99352098e-01f, 9.99935210e-01f, 7.65414059e-01f, 6.47921681e-01f, -8.48100007e-01f, 3.90112430e-01f, 9.32327330e-01f, 9.93162811e-01f, 9.99315560e-01f, 9.99931574e-01f, 9.55073655e-01f, 8.52673113e-01f, -7.90967762e-01f, 3.60805035e-01f, 9.28664625e-01f, 9.92788672e-01f, 9.99278069e-01f, 9.99927819e-01f, 2.66642928e-01f, 9.72865343e-01f, -7.25932240e-01f, 3.31136853e-01f, 9.24909055e-01f, 9.92404640e-01f, 9.99239624e-01f, 9.99923944e-01f, -6.66938066e-01f, 9.96578991e-01f, -6.53643608e-01f, 3.01137596e-01f, 9.21060979e-01f, 9.92010653e-01f, 9.99200106e-01f, 9.99920011e-01f, -9.87339258e-01f, 9.21462357e-01f, -5.74824035e-01f, 2.70837069e-01f, 9.17120814e-01f, 9.91606772e-01f, 9.99159634e-01f, 9.99915957e-01f, -3.99985313e-01f, 7.54965365e-01f, -4.90260571e-01f, 2.40265876e-01f, 9.13088918e-01f, 9.91192937e-01f, 9.99118149e-01f, 9.99911785e-01f, 5.55113316e-01f, 5.13598442e-01f, -4.00799006e-01f, 2.09454417e-01f, 9.08965766e-01f, 9.90769207e-01f, 9.99075651e-01f, 9.99907553e-01f, 9.99843299e-01f, 2.21298173e-01f, -3.07332784e-01f, 1.78433523e-01f, 9.04751658e-01f, 9.90335584e-01f, 9.99032140e-01f, 9.99903202e-01f, 5.25321960e-01f, -9.29481089e-02f, -2.10795805e-01f, 1.47234216e-01f, 9.00447130e-01f, 9.89892066e-01f, 9.98987675e-01f, 9.99898732e-01f, -4.32177931e-01f, -3.97976756e-01f, -1.12152621e-01f, 1.15887694e-01f, 8.96052480e-01f, 9.89438653e-01f, 9.98942196e-01f, 9.99894202e-01f, -9.92335498e-01f, -6.63538277e-01f, -1.23883775e-02f, 8.44252855e-02f, 8.91568303e-01f, 9.88975346e-01f, 9.98895705e-01f, 9.99889553e-01f, -6.40144348e-01f, -8.63296509e-01f, 8.74991715e-02f, 5.28784581e-02f, 8.86994898e-01f, 9.88502085e-01f, 9.98848200e-01f, 9.99884784e-01f, 3.00592542e-01f, -9.77442741e-01f, 1.86512470e-01f, 2.12787576e-02f, 8.82332861e-01f, 9.88018990e-01f, 9.98799741e-01f, 9.99879956e-01f, 9.64965999e-01f, -9.94656444e-01f, 2.83662200e-01f, -1.03422189e-02f, 8.77582550e-01f, 9.87526000e-01f, 9.98750269e-01f, 9.99875009e-01f, 7.42154181e-01f, -9.13230121e-01f, 3.77977669e-01f, -4.19528559e-02f, 8.72744501e-01f, 9.87023175e-01f, 9.98699784e-01f, 9.99869943e-01f, -1.62990779e-01f, -7.41239965e-01f, 4.68516916e-01f, -7.35215396e-02f, 8.67819190e-01f, 9.86510456e-01f, 9.98648286e-01f, 9.99864817e-01f, -9.18282807e-01f, -4.95741814e-01f, 5.54374516e-01f, -1.05016708e-01f, 8.62807095e-01f, 9.85987842e-01f, 9.98595834e-01f, 9.99859571e-01f, -8.29309821e-01f, -2.01079622e-01f, 6.34692967e-01f, -1.36406869e-01f, 8.57708693e-01f, 9.85455394e-01f, 9.98542368e-01f, 9.99854207e-01f, 2.21267566e-02f, 1.13521777e-01f, 7.08669782e-01f, -1.67660639e-01f, 8.52524519e-01f, 9.84913111e-01f, 9.98487890e-01f, 9.99848783e-01f, 8.53220105e-01f, 4.16867077e-01f, 7.75565803e-01f, -1.98746875e-01f, 8.47255111e-01f, 9.84360933e-01f, 9.98432398e-01f, 9.99843180e-01f, 8.99866819e-01f, 6.78870201e-01f, 8.34712923e-01f, -2.29634270e-01f, 8.41901004e-01f, 9.83798921e-01f, 9.98375952e-01f, 9.99837577e-01f, 1.19180135e-01f, 8.73550534e-01f, 8.85519624e-01f, -2.60292053e-01f, 8.36462677e-01f, 9.83227074e-01f, 9.98318493e-01f, 9.99831796e-01f, -7.71080196e-01f, 9.81602073e-01f, 9.27478492e-01f, -2.90689558e-01f, 8.30940723e-01f, 9.82645452e-01f, 9.98260021e-01f, 9.99825954e-01f, -9.52412963e-01f, 9.92308319e-01f, 9.60170269e-01f, -3.20796400e-01f, 8.25335622e-01f, 9.82053936e-01f, 9.98200536e-01f, 9.99819994e-01f, -2.58101642e-01f, 9.04607594e-01f, 9.83268440e-01f, -3.50582451e-01f, 8.19648027e-01f, 9.81452644e-01f, 9.98140097e-01f, 9.99813974e-01f, 6.73507154e-01f, 7.27198064e-01f, 9.96542096e-01f, -3.80017966e-01f, 8.13878477e-01f, 9.80841517e-01f, 9.98078644e-01f, 9.99807835e-01f, 9.85896587e-01f, 4.77671444e-01f, 9.99858618e-01f, -4.09073502e-01f, 8.08027506e-01f, 9.80220556e-01f, 9.98016179e-01f, 9.99801576e-01f };
__device__ const float ROPE_SIN_8[512] = { 0.00000000e+00f, 0.00000000e+00f, 0.00000000e+00f, 0.00000000e+00f, 0.00000000e+00f, 0.00000000e+00f, 0.00000000e+00f, 0.00000000e+00f, 8.41470957e-01f, 3.10983598e-01f, 9.98334214e-02f, 3.16175036e-02f, 9.99983307e-03f, 3.16227227e-03f, 9.99999931e-04f, 3.16227757e-04f, 9.09297407e-01f, 5.91127098e-01f, 1.98669329e-01f, 6.32033944e-02f, 1.99986659e-02f, 6.32451288e-03f, 1.99999870e-03f, 6.32455456e-04f, 1.41120002e-01f, 8.12648892e-01f, 2.95520216e-01f, 9.47260857e-02f, 2.99954992e-02f, 9.48669016e-03f, 2.99999560e-03f, 9.48683126e-04f, -7.56802499e-01f, 9.53580737e-01f, 3.89418334e-01f, 1.26154065e-01f, 3.99893336e-02f, 1.26487734e-02f, 3.99998948e-03f, 1.26491068e-03f, -9.58924294e-01f, 9.99946535e-01f, 4.79425550e-01f, 1.57455876e-01f, 4.99791652e-02f, 1.58107281e-02f, 4.99997940e-03f, 1.58113812e-03f, -2.79415488e-01f, 9.47148204e-01f, 5.64642489e-01f, 1.88600272e-01f, 5.99640049e-02f, 1.89725272e-02f, 5.99996420e-03f, 1.89736532e-03f, 6.56986594e-01f, 8.00421596e-01f, 6.44217670e-01f, 2.19556093e-01f, 6.99428469e-02f, 2.21341345e-02f, 6.99994294e-03f, 2.21359241e-03f, 9.89358246e-01f, 5.74317753e-01f, 7.17356086e-01f, 2.50292331e-01f, 7.99146891e-02f, 2.52955221e-02f, 7.99991470e-03f, 2.52981926e-03f, 4.12118495e-01f, 2.91259229e-01f, 7.83326924e-01f, 2.80778319e-01f, 8.98785442e-02f, 2.84566563e-02f, 8.99987947e-03f, 2.84604589e-03f, -5.44021130e-01f, -2.06835698e-02f, 8.41470957e-01f, 3.10983568e-01f, 9.98334140e-02f, 3.16175036e-02f, 9.99983400e-03f, 3.16227227e-03f, -9.99990225e-01f, -3.30574960e-01f, 8.91207397e-01f, 3.40877861e-01f, 1.09778300e-01f, 3.47780399e-02f, 1.09997792e-02f, 3.47849843e-03f, -5.36572933e-01f, -6.07683420e-01f, 9.32039082e-01f, 3.70431304e-01f, 1.19712204e-01f, 3.79382223e-02f, 1.19997123e-02f, 3.79472389e-03f, 4.20167029e-01f, -8.24528456e-01f, 9.63558197e-01f, 3.99614304e-01f, 1.29634142e-01f, 4.10980321e-02f, 1.29996343e-02f, 4.11094911e-03f, 9.90607381e-01f, -9.59605396e-01f, 9.85449731e-01f, 4.28397775e-01f, 1.39543116e-01f, 4.42574248e-02f, 1.39995432e-02f, 4.42717411e-03f, 6.50287867e-01f, -9.99518692e-01f, 9.97494996e-01f, 4.56752867e-01f, 1.49438128e-01f, 4.74163815e-02f, 1.49994381e-02f, 4.74339863e-03f, -2.87903309e-01f, -9.40310359e-01f, 9.99573588e-01f, 4.84651238e-01f, 1.59318209e-01f, 5.05748577e-02f, 1.59993190e-02f, 5.05962269e-03f, -9.61397469e-01f, -7.87851870e-01f, 9.91664827e-01f, 5.12064993e-01f, 1.69182345e-01f, 5.37328273e-02f, 1.69991814e-02f, 5.37584582e-03f, -7.50987232e-01f, -5.57262897e-01f, 9.73847628e-01f, 5.38966715e-01f, 1.79029569e-01f, 5.68902642e-02f, 1.79990288e-02f, 5.69206895e-03f, 1.49877205e-01f, -2.71410108e-01f, 9.46300089e-01f, 5.65329552e-01f, 1.88858896e-01f, 6.00471310e-02f, 1.89988576e-02f, 6.00829115e-03f, 9.12945271e-01f, 4.13582884e-02f, 9.09297407e-01f, 5.91127038e-01f, 1.98669314e-01f, 6.32033944e-02f, 1.99986678e-02f, 6.32451288e-03f, 8.36655617e-01f, 3.50024760e-01f, 8.63209307e-01f, 6.16333544e-01f, 2.08459899e-01f, 6.63590282e-02f, 2.09984574e-02f, 6.64073415e-03f, -8.85130931e-03f, 6.23979926e-01f, 8.08496356e-01f, 6.40923738e-01f, 2.18229622e-01f, 6.95140064e-02f, 2.19982266e-02f, 6.95695449e-03f, -8.46220434e-01f, 8.36055279e-01f, 7.45705247e-01f, 6.64873064e-01f, 2.27977514e-01f, 7.26682767e-02f, 2.29979735e-02f, 7.27317436e-03f, -9.05578375e-01f, 9.65219259e-01f, 6.75463140e-01f, 6.88157499e-01f, 2.37702623e-01f, 7.58218244e-02f, 2.39976961e-02f, 7.58939330e-03f, -1.32351756e-01f, 9.98663187e-01f, 5.98472118e-01f, 7.10753918e-01f, 2.47403964e-01f, 7.89746121e-02f, 2.49973964e-02f, 7.90561177e-03f, 7.62558460e-01f, 9.33070183e-01f, 5.15501261e-01f, 7.32639611e-01f, 2.57080555e-01f, 8.21266174e-02f, 2.59970706e-02f, 8.22182931e-03f, 9.56375957e-01f, 7.74945021e-01f, 4.27379847e-01f, 7.53792703e-01f, 2.66731411e-01f, 8.52777958e-02f, 2.69967206e-02f, 8.53804592e-03f, 2.70905793e-01f, 5.39968967e-01f, 3.34988207e-01f, 7.74192095e-01f, 2.76355654e-01f, 8.84281173e-02f, 2.79963426e-02f, 8.85426160e-03f, -6.63633883e-01f, 2.51445323e-01f, 2.39249229e-01f, 7.93817401e-01f, 2.85952210e-01f, 9.15775672e-02f, 2.89959367e-02f, 9.17047635e-03f, -9.88031626e-01f, -6.20148405e-02f, 1.41120002e-01f, 8.12648892e-01f, 2.95520186e-01f, 9.47260931e-02f, 2.99955010e-02f, 9.48669016e-03f, -4.04037654e-01f, -3.69325012e-01f, 4.15805206e-02f, 8.30667794e-01f, 3.05058628e-01f, 9.78736654e-02f, 3.09950355e-02f, 9.80290305e-03f, 5.51426709e-01f, -6.40009403e-01f, -5.83741926e-02f, 8.47856104e-01f, 3.14566553e-01f, 1.01020269e-01f, 3.19945402e-02f, 1.01191159e-02f, 9.99911845e-01f, -8.47224355e-01f, -1.57745644e-01f, 8.64196658e-01f, 3.24043006e-01f, 1.04165860e-01f, 3.29940096e-02f, 1.04353270e-02f, 5.29082716e-01f, -9.70420420e-01f, -2.55541205e-01f, 8.79673064e-01f, 3.33487093e-01f, 1.07310407e-01f, 3.39934528e-02f, 1.07515370e-02f, -4.28182662e-01f, -9.97380435e-01f, -3.50783229e-01f, 8.94269884e-01f, 3.42897803e-01f, 1.10453881e-01f, 3.49928550e-02f, 1.10677453e-02f, -9.91778851e-01f, -9.25431013e-01f, -4.42520559e-01f, 9.07972515e-01f, 3.52274209e-01f, 1.13596253e-01f, 3.59922275e-02f, 1.13839535e-02f, -6.43538117e-01f, -7.61706948e-01f, -5.29836178e-01f, 9.20767248e-01f, 3.61615449e-01f, 1.16737492e-01f, 3.69915590e-02f, 1.17001599e-02f, 2.96368569e-01f, -5.22444785e-01f, -6.11857831e-01f, 9.32641268e-01f, 3.70920479e-01f, 1.19877554e-01f, 3.79908569e-02f, 1.20163653e-02f, 9.63795364e-01f, -2.31372014e-01f, -6.87766254e-01f, 9.43582714e-01f, 3.80188406e-01f, 1.23016424e-01f, 3.89901139e-02f, 1.23325698e-02f, 7.45113134e-01f, 8.26458037e-02f, -7.56802499e-01f, 9.53580678e-01f, 3.89418334e-01f, 1.26154065e-01f, 3.99893373e-02f, 1.26487734e-02f, -1.58622667e-01f, 3.88467699e-01f, -8.18277061e-01f, 9.62625206e-01f, 3.98609310e-01f, 1.29290432e-01f, 4.09885161e-02f, 1.29649751e-02f, -9.16521549e-01f, 6.55764699e-01f, -8.71575892e-01f, 9.70707119e-01f, 4.07760441e-01f, 1.32425532e-01f, 4.19876575e-02f, 1.32811759e-02f, -8.31774771e-01f, 8.58030677e-01f, -9.16166008e-01f, 9.77818429e-01f, 4.16870773e-01f, 1.35559291e-01f, 4.29867506e-02f, 1.35973748e-02f, 1.77019257e-02f, 9.75206196e-01f, -9.51602101e-01f, 9.83951986e-01f, 4.25939471e-01f, 1.38691694e-01f, 4.39858064e-02f, 1.39135728e-02f, 8.50903511e-01f, 9.95670974e-01f, -9.77530122e-01f, 9.89101648e-01f, 4.34965521e-01f, 1.41822711e-01f, 4.49848175e-02f, 1.42297689e-02f, 9.01788354e-01f, 9.17395473e-01f, -9.93690968e-01f, 9.93262351e-01f, 4.43948090e-01f, 1.44952312e-01f, 4.59837839e-02f, 1.45459641e-02f, 1.23573124e-01f, 7.48142362e-01f, -9.99923289e-01f, 9.96429801e-01f, 4.52886283e-01f, 1.48080453e-01f, 4.69827019e-02f, 1.48621574e-02f, -7.68254638e-01f, 5.04697084e-01f, -9.96164620e-01f, 9.98600960e-01f, 4.61779177e-01f, 1.51207119e-01f, 4.79815714e-02f, 1.51783489e-02f, -9.53752637e-01f, 2.11200655e-01f, -9.82452571e-01f, 9.99773562e-01f, 4.70625877e-01f, 1.54332280e-01f, 4.89803962e-02f, 1.54945394e-02f, -2.62374848e-01f, -1.03240460e-01f, -9.58924294e-01f, 9.99946535e-01f, 4.79425550e-01f, 1.57455891e-01f, 4.99791689e-02f, 1.58107281e-02f, 6.70229197e-01f, -4.07444149e-01f, -9.25814748e-01f, 9.99119580e-01f, 4.88177240e-01f, 1.60577938e-01f, 5.09778969e-02f, 1.61269177e-02f, 9.86627579e-01f, -6.71240151e-01f, -8.83454502e-01f, 9.97293651e-01f, 4.96880114e-01f, 1.63698375e-01f, 5.19765690e-02f, 1.64431017e-02f, 3.95925164e-01f, -8.68469954e-01f, -8.32267344e-01f, 9.94470477e-01f, 5.05533338e-01f, 1.66817173e-01f, 5.29751927e-02f, 1.67592876e-02f, -5.58789074e-01f, -9.79574919e-01f, -7.72764444e-01f, 9.90652919e-01f, 5.14135957e-01f, 1.69934288e-01f, 5.39737605e-02f, 1.70754679e-02f, -9.99755144e-01f, -9.93535519e-01f, -7.05540299e-01f, 9.85844791e-01f, 5.22687256e-01f, 1.73049718e-01f, 5.49722798e-02f, 1.73916500e-02f, -5.21551013e-01f, -9.08967435e-01f, -6.31266713e-01f, 9.80050862e-01f, 5.31186223e-01f, 1.76163420e-01f, 5.59707358e-02f, 1.77078284e-02f, 4.36164767e-01f, -7.34258294e-01f, -5.50685287e-01f, 9.73276973e-01f, 5.39632022e-01f, 1.79275364e-01f, 5.69691435e-02f, 1.80240069e-02f, 9.92872655e-01f, -4.86733496e-01f, -4.64602023e-01f, 9.65529919e-01f, 5.48023939e-01f, 1.82385504e-01f, 5.79674877e-02f, 1.83401816e-02f, 6.36738002e-01f, -1.90938011e-01f, -3.73876572e-01f, 9.56817448e-01f, 5.56361020e-01f, 1.85493827e-01f, 5.89657798e-02f, 1.86563563e-02f, -3.04810613e-01f, 1.23790950e-01f, -2.79415488e-01f, 9.47148204e-01f, 5.64642429e-01f, 1.88600287e-01f, 5.99640086e-02f, 1.89725272e-02f, -9.66117799e-01f, 4.26245421e-01f, -1.82162598e-01f, 9.36531842e-01f, 5.72867453e-01f, 1.91704854e-01f, 6.09621815e-02f, 1.92886982e-02f, -7.39180684e-01f, 6.86427653e-01f, -8.30891207e-02f, 9.24979091e-01f, 5.81035137e-01f, 1.94807529e-01f, 6.19602874e-02f, 1.96048655e-02f, 1.67355701e-01f, 8.78538549e-01f, 1.68140903e-02f, 9.12501454e-01f, 5.89144766e-01f, 1.97908238e-01f, 6.29583374e-02f, 1.99210308e-02f };
__device__ const float ROPE_COS_16[1024] = { 1.00000000e+00f, 1.00000000e+00f, 1.00000000e+00f, 1.00000000e+00f, 1.00000000e+00f, 1.00000000e+00f, 1.00000000e+00f, 1.00000000e+00f, 1.00000000e+00f, 1.00000000e+00f, 1.00000000e+00f, 1.00000000e+00f, 1.00000000e+00f, 1.00000000e+00f, 1.00000000e+00f, 1.00000000e+00f, 5.40302277e-01f, 8.46009135e-01f, 9.50415254e-01f, 9.84230220e-01f, 9.95004177e-01f, 9.98419285e-01f, 9.99500036e-01f, 9.99841869e-01f, 9.99949992e-01f, 9.99984205e-01f, 9.99994993e-01f, 9.99998391e-01f, 9.99999523e-01f, 9.99999821e-01f, 9.99999940e-01f, 1.00000000e+00f, -4.16146845e-01f, 4.31462824e-01f, 8.06578398e-01f, 9.37418282e-01f, 9.80066597e-01f, 9.93682086e-01f, 9.98000681e-01f, 9.99367595e-01f, 9.99800026e-01f, 9.99936759e-01f, 9.99979973e-01f, 9.99993682e-01f, 9.99997973e-01f, 9.99999344e-01f, 9.99999821e-01f, 9.99999940e-01f, -9.89992499e-01f, -1.15966164e-01f, 5.82753658e-01f, 8.61040652e-01f, 9.55336511e-01f, 9.85803485e-01f, 9.95503366e-01f, 9.98577297e-01f, 9.99550045e-01f, 9.99857724e-01f, 9.99954998e-01f, 9.99985754e-01f, 9.99995530e-01f, 9.99998569e-01f, 9.99999523e-01f, 9.99999881e-01f, -6.53643608e-01f, -6.27679706e-01f, 3.01137477e-01f, 7.57506192e-01f, 9.21060979e-01f, 9.74808276e-01f, 9.92010653e-01f, 9.97471273e-01f, 9.99200106e-01f, 9.99747038e-01f, 9.99920011e-01f, 9.99974728e-01f, 9.99992013e-01f, 9.99997497e-01f, 9.99999225e-01f, 9.99999762e-01f, 2.83662200e-01f, -9.46079254e-01f, -1.03423381e-02f, 6.30080283e-01f, 8.77582550e-01f, 9.60731268e-01f, 9.87526000e-01f, 9.96049762e-01f, 9.98750269e-01f, 9.99604762e-01f, 9.99875009e-01f, 9.99960482e-01f, 9.99987483e-01f, 9.99996066e-01f, 9.99998748e-01f, 9.99999583e-01f, 9.60170269e-01f, -9.73103702e-01f, -3.20796400e-01f, 4.82782036e-01f, 8.25335622e-01f, 9.43616986e-01f, 9.82053936e-01f, 9.94313300e-01f, 9.98200536e-01f, 9.99430835e-01f, 9.99819994e-01f, 9.99943078e-01f, 9.99981999e-01f, 9.99994338e-01f, 9.99998212e-01f, 9.99999404e-01f, 7.53902256e-01f, -7.00429797e-01f, -5.99437475e-01f, 3.20257008e-01f, 7.64842212e-01f, 9.23519433e-01f, 9.75599885e-01f, 9.92262423e-01f, 9.97551024e-01f, 9.99225318e-01f, 9.99755025e-01f, 9.99922514e-01f, 9.99975502e-01f, 9.99992251e-01f, 9.99997556e-01f, 9.99999225e-01f, -1.45500034e-01f, -2.12036446e-01f, -8.18632424e-01f, 1.47631213e-01f, 6.96706712e-01f, 9.00502324e-01f, 9.68170285e-01f, 9.89897788e-01f, 9.96801734e-01f, 9.98988271e-01f, 9.99680042e-01f, 9.99898791e-01f, 9.99967992e-01f, 9.99989867e-01f, 9.99996781e-01f, 9.99998987e-01f, -9.11130250e-01f, 3.41660261e-01f, -9.56644177e-01f, -2.96507962e-02f, 6.21609926e-01f, 8.74638259e-01f, 9.59772646e-01f, 9.87220109e-01f, 9.95952725e-01f, 9.98719573e-01f, 9.99595046e-01f, 9.99871910e-01f, 9.99959528e-01f, 9.99987185e-01f, 9.99995947e-01f, 9.99998748e-01f, -8.39071512e-01f, 7.90131867e-01f, -9.99786079e-01f, -2.05997631e-01f, 5.40302277e-01f, 8.46009135e-01f, 9.50415313e-01f, 9.84230220e-01f, 9.95004177e-01f, 9.98419285e-01f, 9.99500036e-01f, 9.99841869e-01f, 9.99949992e-01f, 9.99984205e-01f, 9.99994993e-01f, 9.99998391e-01f, 4.42569796e-03f, 9.95257378e-01f, -9.43779767e-01f, -3.75847399e-01f, 4.53596085e-01f, 8.14705312e-01f, 9.40107584e-01f, 9.80929136e-01f, 9.93956089e-01f, 9.98087406e-01f, 9.99395072e-01f, 9.99808669e-01f, 9.99939501e-01f, 9.99980867e-01f, 9.99993920e-01f, 9.99998093e-01f, 8.43853951e-01f, 8.93861592e-01f, -7.94179380e-01f, -5.33843040e-01f, 3.62357706e-01f, 7.80825913e-01f, 9.28859890e-01f, 9.77317870e-01f, 9.92808640e-01f, 9.97723997e-01f, 9.99280095e-01f, 9.99772310e-01f, 9.99927998e-01f, 9.99977231e-01f, 9.99992788e-01f, 9.99997735e-01f, 9.07446802e-01f, 5.17172873e-01f, -5.65820515e-01f, -6.75001681e-01f, 2.67498761e-01f, 7.44477987e-01f, 9.16683376e-01f, 9.73397553e-01f, 9.91561890e-01f, 9.97329056e-01f, 9.99155104e-01f, 9.99732792e-01f, 9.99915481e-01f, 9.99973297e-01f, 9.99991536e-01f, 9.99997318e-01f, 1.36737213e-01f, -1.87961515e-02f, -2.81349480e-01f, -7.94870913e-01f, 1.69967160e-01f, 7.05776393e-01f, 9.03590262e-01f, 9.69169438e-01f, 9.90216017e-01f, 9.96902585e-01f, 9.99020159e-01f, 9.99690115e-01f, 9.99902010e-01f, 9.99969006e-01f, 9.99990225e-01f, 9.99996901e-01f, -7.59687901e-01f, -5.48975468e-01f, 3.10223512e-02f, -8.89670432e-01f, 7.07371980e-02f, 6.64843500e-01f, 8.89593601e-01f, 9.64634836e-01f, 9.88771081e-01f, 9.96444523e-01f, 9.98875201e-01f, 9.99644279e-01f, 9.99887526e-01f, 9.99964416e-01f, 9.99988735e-01f, 9.99996424e-01f, -9.57659483e-01f, -9.10081089e-01f, 3.40318173e-01f, -9.56410050e-01f, -2.91995462e-02f, 6.21808827e-01f, 8.74707460e-01f, 9.59795177e-01f, 9.87227261e-01f, 9.95954990e-01f, 9.98720288e-01f, 9.99595284e-01f, 9.99872029e-01f, 9.99959528e-01f, 9.99987185e-01f, 9.99995947e-01f, -2.75163352e-01f, -9.90897954e-01f, 6.15864813e-01f, -9.92985010e-01f, -1.28844544e-01f, 5.76808274e-01f, 8.58946681e-01f, 9.54652011e-01f, 9.85584795e-01f, 9.95433986e-01f, 9.98555362e-01f, 9.99543071e-01f, 9.99855518e-01f, 9.99954283e-01f, 9.99985576e-01f, 9.99995410e-01f, 6.60316706e-01f, -7.66536534e-01f, 8.30336154e-01f, -9.98241663e-01f, -2.27202162e-01f, 5.29984176e-01f, 8.42327058e-01f, 9.49207008e-01f, 9.83843684e-01f, 9.94881511e-01f, 9.98380423e-01f, 9.99487758e-01f, 9.99837995e-01f, 9.99948800e-01f, 9.99983788e-01f, 9.99994874e-01f, 9.88704622e-01f, -3.06095392e-01f, 9.62463796e-01f, -9.72014248e-01f, -3.23289543e-01f, 4.81484592e-01f, 8.24865162e-01f, 9.43461835e-01f, 9.82004225e-01f, 9.94297504e-01f, 9.98195529e-01f, 9.99429286e-01f, 9.99819517e-01f, 9.99942899e-01f, 9.99981940e-01f, 9.99994278e-01f, 4.08082068e-01f, 2.48616725e-01f, 9.99144375e-01f, -9.15129960e-01f, -4.16146845e-01f, 4.31462824e-01f, 8.06578457e-01f, 9.37418282e-01f, 9.80066597e-01f, 9.93682086e-01f, 9.98000681e-01f, 9.99367595e-01f, 9.99800026e-01f, 9.99936759e-01f, 9.99979973e-01f, 9.99993682e-01f, -5.47729254e-01f, 7.26760268e-01f, 9.36740458e-01f, -8.29382956e-01f, -5.04846215e-01f, 3.80077004e-01f, 7.87485182e-01f, 9.31078374e-01f, 9.78030920e-01f, 9.93035257e-01f, 9.97795820e-01f, 9.99302804e-01f, 9.99779522e-01f, 9.99930263e-01f, 9.99977946e-01f, 9.99993026e-01f, -9.99960840e-01f, 9.81074572e-01f, 7.81440377e-01f, -7.17477441e-01f, -5.88501155e-01f, 3.27489585e-01f, 7.67604589e-01f, 9.24443960e-01f, 9.75897431e-01f, 9.92357016e-01f, 9.97581005e-01f, 9.99234855e-01f, 9.99758005e-01f, 9.99923468e-01f, 9.99975801e-01f, 9.99992371e-01f, -5.32833040e-01f, 9.33235765e-01f, 5.48645258e-01f, -5.82943261e-01f, -6.66275978e-01f, 2.73866832e-01f, 7.46956408e-01f, 9.17517304e-01f, 9.73666370e-01f, 9.91647422e-01f, 9.97356176e-01f, 9.99163687e-01f, 9.99735534e-01f, 9.99916375e-01f, 9.99973536e-01f, 9.99991655e-01f, 4.24179018e-01f, 5.97977161e-01f, 2.61441678e-01f, -4.30023283e-01f, -7.37393796e-01f, 2.19378278e-01f, 7.25561321e-01f, 9.10300434e-01f, 9.71337974e-01f, 9.90906477e-01f, 9.97121394e-01f, 9.99089420e-01f, 9.99711990e-01f, 9.99908924e-01f, 9.99971211e-01f, 9.99990880e-01f, 9.91202831e-01f, 7.85522610e-02f, -5.16893305e-02f, -2.63540596e-01f, -8.01143587e-01f, 1.64196163e-01f, 7.03440726e-01f, 9.02795732e-01f, 9.68912423e-01f, 9.90134120e-01f, 9.96876657e-01f, 9.99011934e-01f, 9.99687493e-01f, 9.99901175e-01f, 9.99968767e-01f, 9.99990106e-01f, 6.46919310e-01f, -4.65064496e-01f, -3.59694332e-01f, -8.87455046e-02f, -8.56888831e-01f, 1.08494945e-01f, 6.80616796e-01f, 8.95005584e-01f, 9.66389954e-01f, 9.89330530e-01f, 9.96621907e-01f, 9.98931348e-01f, 9.99662042e-01f, 9.99893129e-01f, 9.99966204e-01f, 9.99989331e-01f, -2.92138815e-01f, -8.65450621e-01f, -6.32028639e-01f, 8.88481140e-02f, -9.04072165e-01f, 5.24506159e-02f, 6.57112300e-01f, 8.86932373e-01f, 9.63770926e-01f, 9.88495648e-01f, 9.96357203e-01f, 9.98847544e-01f, 9.99635518e-01f, 9.99884725e-01f, 9.99963522e-01f, 9.99988496e-01f, -9.62605894e-01f, -9.99293387e-01f, -8.41684937e-01f, 2.63639510e-01f, -9.42222297e-01f, -3.75941908e-03f, 6.32950664e-01f, 8.78578722e-01f, 9.61055458e-01f, 9.87629473e-01f, 9.96082544e-01f, 9.98760641e-01f, 9.99608040e-01f, 9.99876022e-01f, 9.99960780e-01f, 9.99987602e-01f, -7.48057544e-01f, -8.25371623e-01f, -9.67871487e-01f, 4.30115849e-01f, -9.70958173e-01f, -5.99575676e-02f, 6.08156204e-01f, 8.69947195e-01f, 9.58243906e-01f, 9.86732066e-01f, 9.95797932e-01f, 9.98670578e-01f, 9.99579549e-01f, 9.99867022e-01f, 9.99957979e-01f, 9.99986708e-01f, 1.54251456e-01f, -3.97251874e-01f, -9.98075247e-01f, 5.83026946e-01f, -9.89992499e-01f, -1.15966164e-01f, 5.82753658e-01f, 8.61040652e-01f, 9.55336511e-01f, 9.85803485e-01f, 9.95503366e-01f, 9.98577297e-01f, 9.99550045e-01f, 9.99857724e-01f, 9.99954998e-01f, 9.99985754e-01f, 9.14742351e-01f, 1.53215483e-01f, -9.29300308e-01f, 7.17549205e-01f, -9.99135137e-01f, -1.71608135e-01f, 5.56768358e-01f, 8.51861775e-01f, 9.52333570e-01f, 9.84843671e-01f, 9.95198846e-01f, 9.98480916e-01f, 9.99519527e-01f, 9.99848068e-01f, 9.99951959e-01f, 9.99984801e-01f, 8.34223390e-01f, 6.56495154e-01f, -7.68367112e-01f, 8.29440355e-01f, -9.98294771e-01f, -2.26707578e-01f, 5.30226350e-01f, 8.42413545e-01f, 9.49235439e-01f, 9.83852804e-01f, 9.94884372e-01f, 9.98381376e-01f, 9.99488056e-01f, 9.99838114e-01f, 9.99948800e-01f, 9.99983788e-01f, -1.32767474e-02f, 9.57586050e-01f, -5.31235278e-01f, 9.15171385e-01f, -9.87479806e-01f, -2.81090319e-01f, 5.03154159e-01f, 8.32698941e-01f, 9.46042359e-01f, 9.82830763e-01f, 9.94559944e-01f, 9.98278618e-01f, 9.99455571e-01f, 9.99827802e-01f, 9.99945521e-01f, 9.99982774e-01f, -8.48570287e-01f, 9.63757515e-01f, -2.41421118e-01f, 9.72038329e-01f, -9.66798186e-01f, -3.34584385e-01f, 4.75578904e-01f, 8.22721004e-01f, 9.42754686e-01f, 9.81777668e-01f, 9.94225562e-01f, 9.98172760e-01f, 9.99422073e-01f, 9.99817252e-01f, 9.99942183e-01f, 9.99981701e-01f, -9.03692186e-01f, 6.73110247e-01f, 7.23346695e-02f, 9.98247743e-01f, -9.36456680e-01f, -3.87020677e-01f, 4.47528064e-01f, 8.12482953e-01f, 9.39372718e-01f, 9.80693519e-01f, 9.93881226e-01f, 9.98063743e-01f, 9.99387562e-01f, 9.99806345e-01f, 9.99938726e-01f, 9.99980628e-01f, -1.27963692e-01f, 1.75156534e-01f, 3.78916174e-01f, 9.92972851e-01f, -8.96758378e-01f, -4.38233554e-01f, 4.19029742e-01f, 8.01987886e-01f, 9.35896814e-01f, 9.79578316e-01f, 9.93526995e-01f, 9.97951567e-01f, 9.99352098e-01f, 9.99795079e-01f, 9.99935210e-01f, 9.99979496e-01f, 7.65414059e-01f, -3.76742303e-01f, 6.47921681e-01f, 9.56380010e-01f, -8.48100007e-01f, -4.88060862e-01f, 3.90112430e-01f, 7.91239262e-01f, 9.32327330e-01f, 9.78432178e-01f, 9.93162811e-01f, 9.97836173e-01f, 9.99315560e-01f, 9.99783576e-01f, 9.99931574e-01f, 9.99978364e-01f, 9.55073655e-01f, -8.12611222e-01f, 8.52673113e-01f, 8.89623463e-01f, -7.90967762e-01f, -5.36345184e-01f, 3.60805035e-01f, 7.80240417e-01f, 9.28664625e-01f, 9.77255106e-01f, 9.92788672e-01f, 9.97717679e-01f, 9.99278069e-01f, 9.99771714e-01f, 9.99927819e-01f, 9.99977171e-01f, 2.66642928e-01f, -9.98210371e-01f, 9.72865343e-01f, 7.94808388e-01f, -7.25932240e-01f, -5.82933903e-01f, 3.31136853e-01f, 7.68994927e-01f, 9.24909055e-01f, 9.76047099e-01f, 9.92404640e-01f, 9.97596025e-01f, 9.99239624e-01f, 9.99759495e-01f, 9.99923944e-01f, 9.99975979e-01f, -6.66938066e-01f, -8.76379430e-01f, 9.96578991e-01f, 6.74925625e-01f, -6.53643608e-01f, -6.27679706e-01f, 3.01137596e-01f, 7.57506192e-01f, 9.21060979e-01f, 9.74808276e-01f, 9.92010653e-01f, 9.97471273e-01f, 9.99200106e-01f, 9.99747038e-01f, 9.99920011e-01f, 9.99974728e-01f, -9.87339258e-01f, -4.84639406e-01f, 9.21462357e-01f, 5.33756077e-01f, -5.74824035e-01f, -6.70441091e-01f, 2.70837069e-01f, 7.45777905e-01f, 9.17120814e-01f, 9.73538578e-01f, 9.91606772e-01f, 9.97343302e-01f, 9.99159634e-01f, 9.99734223e-01f, 9.99915957e-01f, 9.99973416e-01f, -3.99985313e-01f, 5.63609414e-02f, 7.54965365e-01f, 3.75752151e-01f, -4.90260571e-01f, -7.11082935e-01f, 2.40265876e-01f, 7.33813822e-01f, 9.13088918e-01f, 9.72238123e-01f, 9.91192937e-01f, 9.97212172e-01f, 9.99118149e-01f, 9.99721110e-01f, 9.99911785e-01f, 9.99972105e-01f, 5.55113316e-01f, 5.80003142e-01f, 5.13598442e-01f, 2.05897167e-01f, -4.00799006e-01f, -7.49476731e-01f, 2.09454417e-01f, 7.21617639e-01f, 9.08965766e-01f, 9.70906913e-01f, 9.90769207e-01f, 9.97077882e-01f, 9.99075651e-01f, 9.99707639e-01f, 9.99907553e-01f, 9.99970794e-01f, 9.99843299e-01f, 9.25014675e-01f, 2.21298173e-01f, 2.95478199e-02f, -3.07332784e-01f, -7.85501122e-01f, 1.78433523e-01f, 7.09193349e-01f, 9.04751658e-01f, 9.69545007e-01f, 9.90335584e-01f, 9.96940494e-01f, 9.99032140e-01f, 9.99693930e-01f, 9.99903202e-01f, 9.99969363e-01f, 5.25321960e-01f, 9.85138178e-01f, -9.29481089e-02f, -1.47732988e-01f, -2.10795805e-01f, -8.19042206e-01f, 1.47234216e-01f, 6.96544766e-01f, 9.00447130e-01f, 9.68152404e-01f, 9.89892066e-01f, 9.96799886e-01f, 9.98987675e-01f, 9.99679863e-01f, 9.99898732e-01f, 9.99967992e-01f, -4.32177931e-01f, 7.41858006e-01f, -3.97976756e-01f, -3.20354372e-01f, -1.12152621e-01f, -8.49993885e-01f, 1.15887694e-01f, 6.83675885e-01f, 8.96052480e-01f, 9.66729224e-01f, 9.89438653e-01f, 9.96656179e-01f, 9.98942196e-01f, 9.99665439e-01f, 9.99894202e-01f, 9.99966562e-01f, -9.92335498e-01f, 2.70098448e-01f, -6.63538277e-01f, -4.82871950e-01f, -1.23883775e-02f, -8.78258407e-01f, 8.44252855e-02f, 6.70590878e-01f, 8.91568303e-01f, 9.65275466e-01f, 9.88975346e-01f, 9.96509314e-01f, 9.98895705e-01f, 9.99650776e-01f, 9.99889553e-01f, 9.99965072e-01f, -6.40144348e-01f, -2.84846604e-01f, -8.63296509e-01f, -6.30159974e-01f, 8.74991715e-02f, -9.03746367e-01f, 5.28784581e-02f, 6.57293737e-01f, 8.86994898e-01f, 9.63791192e-01f, 9.88502085e-01f, 9.96359289e-01f, 9.98848200e-01f, 9.99635756e-01f, 9.99884784e-01f, 9.99963582e-01f, 3.00592542e-01f, -7.52063990e-01f, -9.77442741e-01f, -7.57573068e-01f, 1.86512470e-01f, -9.26377118e-01f, 2.12787576e-02f, 6.43788815e-01f, 8.82332861e-01f, 9.62276459e-01f, 9.88018990e-01f, 9.96206105e-01f, 9.98799741e-01f, 9.99620378e-01f, 9.99879956e-01f, 9.99962032e-01f, 9.64965999e-01f, -9.87659097e-01f, -9.94656444e-01f, -8.61092687e-01f, 2.83662200e-01f, -9.46079254e-01f, -1.03422189e-02f, 6.30080283e-01f, 8.77582550e-01f, 9.60731268e-01f, 9.87526000e-01f, 9.96049762e-01f, 9.98750269e-01f, 9.99604762e-01f, 9.99875009e-01f, 9.99960482e-01f, 7.42154181e-01f, -9.19073522e-01f, -9.13230121e-01f, -9.37454224e-01f, 3.77977669e-01f, -9.62790370e-01f, -4.19528559e-02f, 6.16172493e-01f, 8.72744501e-01f, 9.59155679e-01f, 9.87023175e-01f, 9.95890260e-01f, 9.98699784e-01f, 9.99588788e-01f, 9.99869943e-01f, 9.99958873e-01f, -1.62990779e-01f, -5.67430019e-01f, -7.41239965e-01f, -9.84248459e-01f, 4.68516916e-01f, -9.76457715e-01f, -7.35215396e-02f, 6.02069914e-01f, 8.67819190e-01f, 9.57549810e-01f, 9.86510456e-01f, 9.95727658e-01f, 9.98648286e-01f, 9.99572515e-01f, 9.99864817e-01f, 9.99957263e-01f, -9.18282807e-01f, -4.10281904e-02f, -4.95741814e-01f, -1.00000000e+00f, 5.54374516e-01f, -9.87038016e-01f, -1.05016708e-01f, 5.87776959e-01f, 8.62807095e-01f, 9.55913603e-01f, 9.85987842e-01f, 9.95561838e-01f, 9.98595834e-01f, 9.99555886e-01f, 9.99859571e-01f, 9.99955595e-01f, -8.29309821e-01f, 4.98009592e-01f, -2.01079622e-01f, -9.84212041e-01f, 6.34692967e-01f, -9.94497895e-01f, -1.36406869e-01f, 5.73298037e-01f, 8.57708693e-01f, 9.54247177e-01f, 9.85455394e-01f, 9.95392919e-01f, 9.98542368e-01f, 9.99538958e-01f, 9.99854207e-01f, 9.99953866e-01f, 2.21267566e-02f, 8.83669317e-01f, 1.13521777e-01f, -9.37382519e-01f, 7.08669782e-01f, -9.98813629e-01f, -1.67660639e-01f, 5.58637917e-01f, 8.52524519e-01f, 9.52550590e-01f, 9.84913111e-01f, 9.95220840e-01f, 9.98487890e-01f, 9.99521732e-01f, 9.99848783e-01f, 9.99952197e-01f, 8.53220105e-01f, 9.97174621e-01f, 4.16867077e-01f, -8.60988438e-01f, 7.75565803e-01f, -9.99971747e-01f, -1.98746875e-01f, 5.43801069e-01f, 8.47255111e-01f, 9.50823903e-01f, 9.84360933e-01f, 9.95045662e-01f, 9.98432398e-01f, 9.99504209e-01f, 9.99843180e-01f, 9.99950409e-01f, 8.99866819e-01f, 8.03569078e-01f, 6.78870201e-01f, -7.57439196e-01f, 8.34712923e-01f, -9.97968495e-01f, -2.29634270e-01f, 5.28792322e-01f, 8.41901004e-01f, 9.49067116e-01f, 9.83798921e-01f, 9.94867265e-01f, 9.98375952e-01f, 9.99486327e-01f, 9.99837577e-01f, 9.99948621e-01f, 1.19180135e-01f, 3.62476677e-01f, 8.73550534e-01f, -6.30000710e-01f, 8.85519624e-01f, -9.92810190e-01f, -2.60292053e-01f, 5.13616323e-01f, 8.36462677e-01f, 9.47280347e-01f, 9.83227074e-01f, 9.94685769e-01f, 9.98318493e-01f, 9.99468148e-01f, 9.99831796e-01f, 9.99946833e-01f, -7.71080196e-01f, -1.90249100e-01f, 9.81602073e-01f, -4.82692331e-01f, 9.27478492e-01f, -9.84513164e-01f, -2.90689558e-01f, 4.98277903e-01f, 8.30940723e-01f, 9.45463598e-01f, 9.82645452e-01f, 9.94501114e-01f, 9.98260021e-01f, 9.99449670e-01f, 9.99825954e-01f, 9.99944985e-01f, -9.52412963e-01f, -6.84381902e-01f, 9.92308319e-01f, -3.20159167e-01f, 9.60170269e-01f, -9.73103702e-01f, -3.20796400e-01f, 4.82782036e-01f, 8.25335622e-01f, 9.43616986e-01f, 9.82053936e-01f, 9.94313300e-01f, 9.98200536e-01f, 9.99430835e-01f, 9.99819994e-01f, 9.99943078e-01f, -2.58101642e-01f, -9.67739642e-01f, 9.04607594e-01f, -1.47529200e-01f, 9.83268440e-01f, -9.58617806e-01f, -3.50582451e-01f, 4.67133403e-01f, 8.19648027e-01f, 9.41740453e-01f, 9.81452644e-01f, 9.94122326e-01f, 9.98140097e-01f, 9.99411702e-01f, 9.99813974e-01f, 9.99941170e-01f, 6.73507154e-01f, -9.53050017e-01f, 7.27198064e-01f, 2.97537707e-02f, 9.96542096e-01f, -9.41101313e-01f, -3.80017966e-01f, 4.51337039e-01f, 8.13878477e-01f, 9.39834237e-01f, 9.80841517e-01f, 9.93928254e-01f, 9.98078644e-01f, 9.99392271e-01f, 9.99807835e-01f, 9.99939203e-01f, 9.85896587e-01f, -6.44837022e-01f, 4.77671444e-01f, 2.06098333e-01f, 9.99858618e-01f, -9.20609534e-01f, -4.09073502e-01f, 4.35397953e-01f, 8.08027506e-01f, 9.37898219e-01f, 9.80220556e-01f, 9.93731022e-01f, 9.98016179e-01f, 9.99372482e-01f, 9.99801576e-01f, 9.99937236e-01f };
__device__ const float ROPE_SIN_16[1024] = { 0.00000000e+00f, 0.00000000e+00f, 0.00000000e+00f, 0.00000000e+00f, 0.00000000e+00f, 0.00000000e+00f, 0.00000000e+00f, 0.00000000e+00f, 0.00000000e+00f, 0.00000000e+00f, 0.00000000e+00f, 0.00000000e+00f, 0.00000000e+00f, 0.00000000e+00f, 0.00000000e+00f, 0.00000000e+00f, 8.41470957e-01f, 5.33168435e-01f, 3.10983598e-01f, 1.76892191e-01f, 9.98334214e-02f, 5.62044978e-02f, 3.16175036e-02f, 1.77818574e-02f, 9.99983307e-03f, 5.62338345e-03f, 3.16227227e-03f, 1.77827850e-03f, 9.99999931e-04f, 5.62341243e-04f, 3.16227757e-04f, 1.77827940e-04f, 9.09297407e-01f, 9.02130723e-01f, 5.91127098e-01f, 3.48205268e-01f, 1.98669329e-01f, 1.12231314e-01f, 6.32033944e-02f, 3.55580896e-02f, 1.99986659e-02f, 1.12465890e-02f, 6.32451288e-03f, 3.55655141e-03f, 1.99999870e-03f, 1.12468237e-03f, 6.32455456e-04f, 3.55655880e-04f, 1.41120002e-01f, 9.93253171e-01f, 8.12648892e-01f, 5.08536100e-01f, 2.95520216e-01f, 1.67903304e-01f, 9.47260857e-02f, 5.33230826e-02f, 2.99954992e-02f, 1.68694388e-02f, 9.48669016e-03f, 5.33481315e-03f, 2.99999560e-03f, 1.68702309e-03f, 9.48683126e-04f, 5.33483806e-04f, -7.56802499e-01f, 7.78471708e-01f, 9.53580737e-01f, 6.52827978e-01f, 3.89418334e-01f, 2.23044485e-01f, 1.26154065e-01f, 7.10712075e-02f, 3.99893336e-02f, 2.24917568e-02f, 1.26487734e-02f, 7.11305765e-03f, 3.99998948e-03f, 2.24936334e-03f, 1.26491068e-03f, 7.11311703e-04f, -9.58924294e-01f, 3.23935270e-01f, 9.99946535e-01f, 7.76529968e-01f, 4.79425550e-01f, 2.77480543e-01f, 1.57455876e-01f, 8.87968615e-02f, 4.99791652e-02f, 2.81133614e-02f, 1.58107281e-02f, 8.89127981e-03f, 4.99997940e-03f, 2.81170290e-03f, 1.58113812e-03f, 8.89139599e-04f, -2.79415488e-01f, -2.30367512e-01f, 9.47148204e-01f, 8.75740528e-01f, 5.64642489e-01f, 3.31039310e-01f, 1.88600272e-01f, 1.06494442e-01f, 5.99640049e-02f, 3.37340795e-02f, 1.89725272e-02f, 1.06694745e-02f, 5.99996420e-03f, 3.37404152e-03f, 1.89736532e-03f, 1.06696738e-03f, 6.56986594e-01f, -7.13721275e-01f, 8.00421596e-01f, 9.47330713e-01f, 6.44217670e-01f, 3.83551568e-01f, 2.19556093e-01f, 1.24158338e-01f, 6.99428469e-02f, 3.93537246e-02f, 2.21341345e-02f, 1.24476347e-02f, 6.99994294e-03f, 3.93637875e-03f, 2.21359241e-03f, 1.24479528e-03f, 9.89358246e-01f, -9.77261782e-01f, 5.74317753e-01f, 9.89042461e-01f, 7.17356086e-01f, 4.34851229e-01f, 2.50292331e-01f, 1.41782969e-01f, 7.99146891e-02f, 4.49721329e-02f, 2.52955221e-02f, 1.42257558e-02f, 7.99991470e-03f, 4.49871505e-03f, 2.52981926e-03f, 1.42262306e-03f, 4.12118495e-01f, -9.39823508e-01f, 2.91259229e-01f, 9.99560297e-01f, 7.83326924e-01f, 4.84776139e-01f, 2.80778319e-01f, 1.59362778e-01f, 8.98785442e-02f, 5.05891182e-02f, 2.84566563e-02f, 1.60038304e-02f, 8.99987947e-03f, 5.06105041e-03f, 2.84604589e-03f, 1.60045072e-03f, -5.44021130e-01f, -6.12936914e-01f, -2.06835698e-02f, 9.78552461e-01f, 8.41470957e-01f, 5.33168435e-01f, 3.10983568e-01f, 1.76892191e-01f, 9.98334140e-02f, 5.62044978e-02f, 3.16175036e-02f, 1.77818574e-02f, 9.99983400e-03f, 5.62338345e-03f, 3.16227227e-03f, 1.77827850e-03f, -9.99990225e-01f, -9.72764567e-02f, -3.30574960e-01f, 9.26681578e-01f, 8.91207397e-01f, 5.79875171e-01f, 3.40877861e-01f, 1.94365650e-01f, 1.09778300e-01f, 6.18181042e-02f, 3.47780399e-02f, 1.95598267e-02f, 1.09997792e-02f, 6.18571462e-03f, 3.47849843e-03f, 1.95610616e-03f, -5.36572933e-01f, 4.48342979e-01f, -6.07683420e-01f, 8.45583618e-01f, 9.32039082e-01f, 6.24748647e-01f, 3.70431304e-01f, 2.11777672e-01f, 1.19712204e-01f, 6.74297586e-02f, 3.79382223e-02f, 2.13377345e-02f, 1.19997123e-02f, 6.74804440e-03f, 3.79472389e-03f, 2.13393359e-03f, 4.20167029e-01f, 8.55880976e-01f, -8.24528456e-01f, 7.37816215e-01f, 9.63558197e-01f, 6.67647004e-01f, 3.99614304e-01f, 2.29122713e-01f, 1.29634142e-01f, 7.30392784e-02f, 4.10980321e-02f, 2.31155735e-02f, 1.29996343e-02f, 7.31037185e-03f, 4.11094911e-03f, 2.31176103e-03f, 9.90607381e-01f, 9.99823332e-01f, -9.59605396e-01f, 6.06778562e-01f, 9.85449731e-01f, 7.08434701e-01f, 4.28397775e-01f, 2.46395305e-01f, 1.39543116e-01f, 7.86464810e-02f, 4.42574248e-02f, 2.48933397e-02f, 1.39995432e-02f, 7.87269697e-03f, 4.42717411e-03f, 2.48958869e-03f, 6.50287867e-01f, 8.35838437e-01f, -9.99518692e-01f, 4.56603259e-01f, 9.97494996e-01f, 7.46982634e-01f, 4.56752867e-01f, 2.63589978e-01f, 1.49438128e-01f, 8.42512026e-02f, 4.74163815e-02f, 2.66710296e-02f, 1.49994381e-02f, 8.43502022e-03f, 4.74339863e-03f, 2.66741589e-03f, -2.87903309e-01f, 4.14430231e-01f, -9.40310359e-01f, 2.92027086e-01f, 9.99573588e-01f, 7.83169091e-01f, 4.84651238e-01f, 2.80701309e-01f, 1.59318209e-01f, 8.98532644e-02f, 5.05748577e-02f, 2.84486320e-02f, 1.59993190e-02f, 8.99733976e-03f, 5.05962269e-03f, 2.84524332e-03f, -9.61397469e-01f, -1.34615138e-01f, -7.87851870e-01f, 1.18240520e-01f, 9.91664827e-01f, 8.16879570e-01f, 5.12064993e-01f, 2.97723860e-01f, 1.69182345e-01f, 9.54524800e-02f, 5.37328273e-02f, 3.02261449e-02f, 1.69991814e-02f, 9.55965649e-03f, 5.37584582e-03f, 3.02307028e-03f, -7.50987232e-01f, -6.42200708e-01f, -5.57262897e-01f, -5.92755191e-02f, 9.73847628e-01f, 8.48007560e-01f, 5.38966715e-01f, 3.14652264e-01f, 1.79029569e-01f, 1.01048686e-01f, 5.68902642e-02f, 3.20035629e-02f, 1.79990288e-02f, 1.01219704e-02f, 5.69206895e-03f, 3.20089748e-03f, 1.49877205e-01f, -9.52000856e-01f, -2.71410108e-01f, -2.34921798e-01f, 9.46300089e-01f, 8.76454532e-01f, 5.65329552e-01f, 3.31481189e-01f, 1.88858896e-01f, 1.06641680e-01f, 6.00471310e-02f, 3.37808803e-02f, 1.89988576e-02f, 1.06842816e-02f, 6.00829115e-03f, 3.37872445e-03f, 9.12945271e-01f, -9.68601942e-01f, 4.13582884e-02f, -4.03158993e-01f, 9.09297407e-01f, 9.02130723e-01f, 5.91127038e-01f, 3.48205268e-01f, 1.98669314e-01f, 1.12231314e-01f, 6.32033944e-02f, 3.55580896e-02f, 1.99986678e-02f, 1.12465890e-02f, 6.32451288e-03f, 3.55655141e-03f, 8.36655617e-01f, -6.86891198e-01f, 3.50024760e-01f, -5.58680534e-01f, 8.63209307e-01f, 9.24954832e-01f, 6.16333544e-01f, 3.64819258e-01f, 2.08459899e-01f, 1.17817394e-01f, 6.63590282e-02f, 3.73351872e-02f, 2.09984574e-02f, 1.18088927e-02f, 6.64073415e-03f, 3.73437814e-03f, -8.85130931e-03f, -1.93630233e-01f, 6.23979926e-01f, -6.96581721e-01f, 8.08496356e-01f, 9.44854796e-01f, 6.40923738e-01f, 3.81317884e-01f, 2.18229622e-01f, 1.23399742e-01f, 6.95140064e-02f, 3.91121693e-02f, 2.19982266e-02f, 1.23711927e-02f, 6.95695449e-03f, 3.91220488e-03f, -8.46220434e-01f, 3.59264523e-01f, 8.36055279e-01f, -8.12512875e-01f, 7.45705247e-01f, 9.61767614e-01f, 6.64873064e-01f, 3.97695929e-01f, 2.27977514e-01f, 1.28978193e-01f, 7.26682767e-02f, 4.08890247e-02f, 2.29979735e-02f, 1.29334899e-02f, 7.27317436e-03f, 4.09003161e-03f, -9.05578375e-01f, 8.01513135e-01f, 9.65219259e-01f, -9.02817786e-01f, 6.75463140e-01f, 9.75639880e-01f, 6.88157499e-01f, 4.13948208e-01f, 2.37702623e-01f, 1.34552568e-01f, 7.58218244e-02f, 4.26657498e-02f, 2.39976961e-02f, 1.34957815e-02f, 7.58939330e-03f, 4.26785741e-03f, -1.32351756e-01f, 9.96909976e-01f, 9.98663187e-01f, -9.64648306e-01f, 5.98472118e-01f, 9.86427724e-01f, 7.10753918e-01f, 4.30069596e-01f, 2.47403964e-01f, 1.40122697e-01f, 7.89746121e-02f, 4.44423407e-02f, 2.49973964e-02f, 1.40580693e-02f, 7.90561177e-03f, 4.44568414e-03f, 7.62558460e-01f, 8.85276794e-01f, 9.33070183e-01f, -9.96054351e-01f, 5.15501261e-01f, 9.94096994e-01f, 7.32639611e-01f, 4.46054995e-01f, 2.57080555e-01f, 1.45688385e-01f, 8.21266174e-02f, 4.62187938e-02f, 2.59970706e-02f, 1.46203535e-02f, 8.22182931e-03f, 4.62350994e-03f, 9.56375957e-01f, 5.00994205e-01f, 7.74945021e-01f, -9.96045172e-01f, 4.27379847e-01f, 9.98623490e-01f, 7.53792703e-01f, 4.61899310e-01f, 2.66731411e-01f, 1.51249468e-01f, 8.52777958e-02f, 4.79951017e-02f, 2.69967206e-02f, 1.51826320e-02f, 8.53804592e-03f, 4.80133574e-03f, 2.70905793e-01f, -3.75856608e-02f, 5.39968967e-01f, -9.64621305e-01f, 3.34988207e-01f, 9.99992907e-01f, 7.74192095e-01f, 4.77597594e-01f, 2.76355654e-01f, 1.56805754e-01f, 8.84281173e-02f, 4.97712530e-02f, 2.79963426e-02f, 1.57449059e-02f, 8.85426160e-03f, 4.97916201e-03f, -6.63633883e-01f, -5.64589798e-01f, 2.51445323e-01f, -9.02773678e-01f, 2.39249229e-01f, 9.98200953e-01f, 7.93817401e-01f, 4.93144840e-01f, 2.85952210e-01f, 1.62357092e-01f, 9.15775672e-02f, 5.15472479e-02f, 2.89959367e-02f, 1.63071752e-02f, 9.17047635e-03f, 5.15698735e-03f, -9.88031626e-01f, -9.17709649e-01f, -6.20148405e-02f, -8.12452853e-01f, 1.41120002e-01f, 9.93253171e-01f, 8.12648892e-01f, 5.08536100e-01f, 2.95520186e-01f, 1.67903304e-01f, 9.47260931e-02f, 5.33230826e-02f, 2.99955010e-02f, 1.68694388e-02f, 9.48669016e-03f, 5.33481315e-03f, -4.04037654e-01f, -9.88192797e-01f, -3.69325012e-01f, -6.96507812e-01f, 4.15805206e-02f, 9.85165298e-01f, 8.30667794e-01f, 5.23766637e-01f, 3.05058628e-01f, 1.73444211e-01f, 9.78736654e-02f, 5.50987460e-02f, 3.09950355e-02f, 1.74316969e-02f, 9.80290305e-03f, 5.51263802e-03f, 5.51426709e-01f, -7.54330218e-01f, -6.40009403e-01f, -5.58595300e-01f, -5.83741926e-02f, 9.73962843e-01f, 8.47856104e-01f, 5.38831532e-01f, 3.14566553e-01f, 1.78979620e-01f, 1.01020269e-01f, 5.68742342e-02f, 3.19945402e-02f, 1.79939512e-02f, 1.01191159e-02f, 5.69046335e-03f, 9.99911845e-01f, -2.88147390e-01f, -8.47224355e-01f, -4.03064936e-01f, -1.57745644e-01f, 9.59681332e-01f, 8.64196658e-01f, 5.53726017e-01f, 3.24043006e-01f, 1.84509367e-01f, 1.04165860e-01f, 5.86495437e-02f, 3.29940096e-02f, 1.85561981e-02f, 1.04353270e-02f, 5.86828869e-03f, 5.29082716e-01f, 2.66779721e-01f, -9.70420420e-01f, -2.34822124e-01f, -2.55541205e-01f, 9.42365825e-01f, 8.79673064e-01f, 5.68445385e-01f, 3.33487093e-01f, 1.90033287e-01f, 1.07310407e-01f, 6.04246669e-02f, 3.39934528e-02f, 1.91184394e-02f, 1.07515370e-02f, 6.04611309e-03f, -4.28182662e-01f, 7.39542127e-01f, -9.97380435e-01f, -5.91726787e-02f, -3.50783229e-01f, 9.22071040e-01f, 8.94269884e-01f, 5.82984984e-01f, 3.42897803e-01f, 1.95551202e-01f, 1.10453881e-01f, 6.21996038e-02f, 3.49928550e-02f, 1.96806751e-02f, 1.10677453e-02f, 6.22393796e-03f, -9.91778851e-01f, 9.84540582e-01f, -9.25431013e-01f, 1.18342586e-01f, -4.42520559e-01f, 8.98861170e-01f, 9.07972515e-01f, 5.97340286e-01f, 3.52274209e-01f, 2.01062918e-01f, 1.13596253e-01f, 6.39743358e-02f, 3.59922275e-02f, 2.02429052e-02f, 1.13839535e-02f, 6.40176190e-03f, -6.43538117e-01f, 9.26318109e-01f, -7.61706948e-01f, 2.92125374e-01f, -5.29836178e-01f, 8.72809589e-01f, 9.20767248e-01f, 6.11506701e-01f, 3.61615449e-01f, 2.06568271e-01f, 1.16737492e-01f, 6.57488778e-02f, 3.69915590e-02f, 2.08051261e-02f, 1.17001599e-02f, 6.57958630e-03f, 2.96368569e-01f, 5.82806170e-01f, -5.22444785e-01f, 4.56694692e-01f, -6.11857831e-01f, 8.43998730e-01f, 9.32641268e-01f, 6.25479698e-01f, 3.70920479e-01f, 2.12067112e-01f, 1.19877554e-01f, 6.75232038e-02f, 3.79908569e-02f, 2.13673431e-02f, 1.20163653e-02f, 6.75741071e-03f, 9.63795364e-01f, 5.98003156e-02f, -2.31372014e-01f, 6.06860459e-01f, -6.87766254e-01f, 8.12519610e-01f, 9.43582714e-01f, 6.39254928e-01f, 3.80188406e-01f, 2.17559248e-01f, 1.23016424e-01f, 6.92973137e-02f, 3.89901139e-02f, 2.19295528e-02f, 1.23325698e-02f, 6.93523418e-03f, 7.45113134e-01f, -4.81621295e-01f, 8.26458037e-02f, 7.37885714e-01f, -7.56802499e-01f, 7.78471708e-01f, 9.53580678e-01f, 6.52827978e-01f, 3.89418334e-01f, 2.23044485e-01f, 1.26154065e-01f, 7.10712075e-02f, 3.99893373e-02f, 2.24917568e-02f, 1.26487734e-02f, 7.11305765e-03f, -1.58622667e-01f, -8.74714017e-01f, 3.88467699e-01f, 8.45638454e-01f, -8.18277061e-01f, 7.41962790e-01f, 9.62625206e-01f, 6.66194677e-01f, 3.98609310e-01f, 2.28522688e-01f, 1.29290432e-01f, 7.28448778e-02f, 4.09885161e-02f, 2.30539497e-02f, 1.29649751e-02f, 7.29088066e-03f, -9.16521549e-01f, -9.98410463e-01f, 6.55764699e-01f, 9.26720202e-01f, -8.71575892e-01f, 7.03108132e-01f, 9.70707119e-01f, 6.79350674e-01f, 4.07760441e-01f, 2.33993664e-01f, 1.32425532e-01f, 7.46183172e-02f, 4.19876575e-02f, 2.36161388e-02f, 1.32811759e-02f, 7.46870413e-03f, -8.31774771e-01f, -8.14614236e-01f, 8.58030677e-01f, 9.78573620e-01f, -9.16166008e-01f, 6.62030637e-01f, 9.77818429e-01f, 6.92291796e-01f, 4.16870773e-01f, 2.39457220e-01f, 1.35559291e-01f, 7.63915181e-02f, 4.29867506e-02f, 2.41783205e-02f, 1.35973748e-02f, 7.64652714e-03f, 1.77019257e-02f, -3.79931390e-01f, 9.75206196e-01f, 9.99563396e-01f, -9.51602101e-01f, 6.18860185e-01f, 9.83951986e-01f, 7.05014050e-01f, 4.25939471e-01f, 2.44913206e-01f, 1.38691694e-01f, 7.81644881e-02f, 4.39858064e-02f, 2.47404929e-02f, 1.39135728e-02f, 7.82434922e-03f, 8.50903511e-01f, 1.71763569e-01f, 9.95670974e-01f, 9.89027262e-01f, -9.77530122e-01f, 5.73733270e-01f, 9.89101648e-01f, 7.17513323e-01f, 4.34965521e-01f, 2.50361472e-01f, 1.41822711e-01f, 7.99371973e-02f, 4.49848175e-02f, 2.53026579e-02f, 1.42297689e-02f, 8.00217129e-03f, 9.01788354e-01f, 6.70557022e-01f, 9.17395473e-01f, 9.47297752e-01f, -9.93690968e-01f, 5.26792526e-01f, 9.93262351e-01f, 7.29785740e-01f, 4.43948090e-01f, 2.55801797e-01f, 1.44952312e-01f, 8.17096606e-02f, 4.59837839e-02f, 2.58648153e-02f, 1.45459641e-02f, 8.17999430e-03f, 1.23573124e-01f, 9.62832689e-01f, 7.48142362e-01f, 8.75690997e-01f, -9.99923289e-01f, 4.78186339e-01f, 9.96429801e-01f, 7.41827428e-01f, 4.52886283e-01f, 2.61234075e-01f, 1.48080453e-01f, 8.34818557e-02f, 4.69827019e-02f, 2.64269635e-02f, 1.48621574e-02f, 8.35781638e-03f, -7.68254638e-01f, 9.58573103e-01f, 5.04697084e-01f, 7.76465356e-01f, -9.96164620e-01f, 4.28068399e-01f, 9.98600960e-01f, 7.53634512e-01f, 4.61779177e-01f, 2.66658038e-01f, 1.51207119e-01f, 8.52537975e-02f, 4.79815714e-02f, 2.69891042e-02f, 1.51783489e-02f, 8.53563752e-03f, -9.53752637e-01f, 6.59090102e-01f, 2.11200655e-01f, 6.52750373e-01f, -9.82452571e-01f, 3.76597136e-01f, 9.99773562e-01f, 7.65203178e-01f, 4.70625877e-01f, 2.72073567e-01f, 1.54332280e-01f, 8.70254710e-02f, 4.89803962e-02f, 2.75512375e-02f, 1.54945394e-02f, 8.71345960e-03f, -2.62374848e-01f, 1.56619072e-01f, -1.03240460e-01f, 5.08447945e-01f, -9.58924294e-01f, 3.23935270e-01f, 9.99946535e-01f, 7.76529968e-01f, 4.79425550e-01f, 2.77480543e-01f, 1.57455891e-01f, 8.87968615e-02f, 4.99791689e-02f, 2.81133596e-02f, 1.58107281e-02f, 8.89127981e-03f, 6.70229197e-01f, -3.94086063e-01f, -4.07444149e-01f, 3.48108500e-01f, -9.25814748e-01f, 2.70249337e-01f, 9.99119580e-01f, 7.87611187e-01f, 4.88177240e-01f, 2.82878697e-01f, 1.60577938e-01f, 9.05679762e-02f, 5.09778969e-02f, 2.86754742e-02f, 1.61269177e-02f, 9.06910095e-03f, 9.86627579e-01f, -8.23421597e-01f, -6.71240151e-01f, 1.76790684e-01f, -8.83454502e-01f, 2.15709001e-01f, 9.97293651e-01f, 7.98443377e-01f, 4.96880114e-01f, 2.88267940e-01f, 1.63698375e-01f, 9.23388004e-02f, 5.19765690e-02f, 2.92375814e-02f, 1.64431017e-02f, 9.24692024e-03f, 3.95925164e-01f, -9.99157965e-01f, -8.68469954e-01f, -1.03020677e-04f, -8.32267344e-01f, 1.60486728e-01f, 9.94470477e-01f, 8.09023023e-01f, 5.05533338e-01f, 2.93648034e-01f, 1.66817173e-01f, 9.41093415e-02f, 5.29751927e-02f, 2.97996756e-02f, 1.67592876e-02f, 9.42474138e-03f, -5.58789074e-01f, -8.67171526e-01f, -9.79574919e-01f, -1.76993474e-01f, -7.72764444e-01f, 1.04756832e-01f, 9.90652919e-01f, 8.19346905e-01f, 5.14135957e-01f, 2.99018890e-01f, 1.69934288e-01f, 9.58795771e-02f, 5.39737605e-02f, 3.03617641e-02f, 1.70754679e-02f, 9.60256159e-03f, -9.99755144e-01f, -4.68111664e-01f, -9.93535519e-01f, -3.48301649e-01f, -7.05540299e-01f, 4.86960001e-02f, 9.85844791e-01f, 8.29411685e-01f, 5.22687256e-01f, 3.04380238e-01f, 1.73049718e-01f, 9.76495072e-02f, 5.49722798e-02f, 3.09238415e-02f, 1.73916500e-02f, 9.78038087e-03f, -5.21551013e-01f, 7.51182064e-02f, -9.08967435e-01f, -5.08624554e-01f, -6.31266713e-01f, -7.51878507e-03f, 9.80050862e-01f, 8.39214146e-01f, 5.31186223e-01f, 3.09731960e-01f, 1.76163420e-01f, 9.94191393e-02f, 5.59707358e-02f, 3.14859077e-02f, 1.77078284e-02f, 9.95820016e-03f, 4.36164767e-01f, 5.95211506e-01f, -7.34258294e-01f, -6.52905703e-01f, -5.50685287e-01f, -6.37097955e-02f, 9.73276973e-01f, 8.48751247e-01f, 5.39632022e-01f, 3.15073937e-01f, 1.79275364e-01f, 1.01188451e-01f, 5.69691435e-02f, 3.20479684e-02f, 1.80240069e-02f, 1.01360194e-02f, 9.92872655e-01f, 9.31992829e-01f, -4.86733496e-01f, -7.76594579e-01f, -4.64602023e-01f, -1.19699396e-01f, 9.65529919e-01f, 8.58020008e-01f, 5.48023939e-01f, 3.20405900e-01f, 1.82385504e-01f, 1.02957435e-01f, 5.79674877e-02f, 3.26100141e-02f, 1.83401816e-02f, 1.03138378e-02f, 6.36738002e-01f, 9.81735826e-01f, -1.90938011e-01f, -8.75790000e-01f, -3.73876572e-01f, -1.75310582e-01f, 9.56817448e-01f, 8.67017388e-01f, 5.56361020e-01f, 3.25727791e-01f, 1.85493827e-01f, 1.04726106e-01f, 5.89657798e-02f, 3.31720486e-02f, 1.86563563e-02f, 1.04916561e-02f, -3.04810613e-01f, 7.29123712e-01f, 1.23790950e-01f, -9.47363734e-01f, -2.79415488e-01f, -2.30367512e-01f, 9.47148204e-01f, 8.75740528e-01f, 5.64642429e-01f, 3.31039310e-01f, 1.88600287e-01f, 1.06494442e-01f, 5.99640086e-02f, 3.37340795e-02f, 1.89725272e-02f, 1.06694745e-02f, -9.66117799e-01f, 2.51952261e-01f, 4.26245421e-01f, -9.89057720e-01f, -1.82162598e-01f, -2.84696162e-01f, 9.36531842e-01f, 8.84186864e-01f, 5.72867453e-01f, 3.36340427e-01f, 1.91704854e-01f, 1.08262435e-01f, 6.09621815e-02f, 3.42960916e-02f, 1.92886982e-02f, 1.08472919e-02f, -7.39180684e-01f, -3.02812874e-01f, 6.86427653e-01f, -9.99557257e-01f, -8.30891207e-02f, -3.38124752e-01f, 9.24979091e-01f, 8.92353535e-01f, 5.81035137e-01f, 3.41630876e-01f, 1.94807529e-01f, 1.10030092e-01f, 6.19602874e-02f, 3.48580964e-02f, 1.96048655e-02f, 1.10251084e-02f, 1.67355701e-01f, -7.64320076e-01f, 8.78538549e-01f, -9.78531301e-01f, 1.68140903e-02f, -3.90484393e-01f, 9.12501454e-01f, 9.00238097e-01f, 5.89144766e-01f, 3.46910536e-01f, 1.97908238e-01f, 1.11797392e-01f, 6.29583374e-02f, 3.54200937e-02f, 1.99210308e-02f, 1.12029258e-02f };

#define XB_TMO      128
#define XB_XCNT(j)  (256  + 64 * (j))
#define XB_XSUB(j)  (1280 + 64 * (j))
#define XB_XGEN(j)  (2304 + 64 * (j))
#define XB_TOP      3328
#define XB_TOPGEN   3392
#define XCD_BAR_WORDS 3456
#define XB_SPIN_CAP (1u << 18)

__device__ __forceinline__ unsigned xb_ld(unsigned* p)              { return __hip_atomic_load(p, __ATOMIC_RELAXED, __HIP_MEMORY_SCOPE_AGENT); }
__device__ __forceinline__ unsigned xb_add(unsigned* p, unsigned v) { return __hip_atomic_fetch_add(p, v, __ATOMIC_RELAXED, __HIP_MEMORY_SCOPE_AGENT); }
__device__ __forceinline__ unsigned xb_xcc_id() { return (unsigned)__builtin_amdgcn_s_getreg((3 << 11) | 20) & 0xFu; }
#define XB_SPIN(cond, bar) do { unsigned _sp = 0; while (cond) { __builtin_amdgcn_s_sleep(1); \
    if ((++_sp & 255u) == 0u) { if (xb_ld(&(bar)[XB_TMO])) break; if (_sp > XB_SPIN_CAP) { atomicAdd(&(bar)[XB_TMO], 1u); break; } } } } while (0)

struct XcdBarrier { unsigned* bar; unsigned x; volatile LAS unsigned* st; };

__device__ __forceinline__ XcdBarrier xcd_barrier_post(unsigned* bar, volatile LAS unsigned* st) {
    XcdBarrier b; b.bar = bar; b.x = xb_xcc_id(); b.st = st;
    if (threadIdx.x == 0) (void)xb_add(&bar[XB_XCNT(b.x)], 1u);
    return b;
}
__device__ __forceinline__ void xcd_barrier_complete(unsigned* bar, unsigned x, unsigned& nloc, unsigned& nx) {
    const unsigned G = gridDim.x * gridDim.y * gridDim.z;
    unsigned sum, cnt, mine, sp = 0u;
    for (;;) {
        sum = 0u; cnt = 0u; mine = 0u;
#pragma unroll
        for (unsigned j = 0; j < 16; ++j) { const unsigned c = xb_ld(&bar[XB_XCNT(j)]); sum += c; cnt += (c > 0u) ? 1u : 0u; mine = (j == x) ? c : mine; }
        if (sum == G) break;
        __builtin_amdgcn_s_sleep(1);
        if ((++sp & 255u) == 0u) { if (xb_ld(&bar[XB_TMO])) break; if (sp > XB_SPIN_CAP) { atomicAdd(&bar[XB_TMO], 1u); break; } }
    }
    nloc = mine > 0u ? mine : 1u; nx = cnt > 0u ? cnt : 1u;
}
__device__ __forceinline__ void xcd_barrier(const XcdBarrier& b) {
    asm volatile("s_waitcnt vmcnt(0)" ::: "memory");
    __syncthreads();
    if (threadIdx.x == 0) {
        unsigned* bar = b.bar;
        __builtin_amdgcn_s_waitcnt(0);
        unsigned nloc = b.st[0], nx = b.st[1];
        if (nloc == 0u) { xcd_barrier_complete(bar, b.x, nloc, nx); b.st[0] = nloc; b.st[1] = nx; }
        const unsigned old = xb_add(&bar[XB_XSUB(b.x)], 1u);
        const unsigned gen = old / nloc;
        if (old + 1u == (gen + 1u) * nloc) {
            __builtin_amdgcn_fence(__ATOMIC_RELEASE, "agent");
            asm volatile("s_waitcnt vmcnt(0)" ::: "memory");
            const unsigned og = xb_add(&bar[XB_TOP], 1u);
            const unsigned tg = og / nx;
            if (og + 1u == (tg + 1u) * nx) xb_add(&bar[XB_TOPGEN], 1u);
            else XB_SPIN(xb_ld(&bar[XB_TOPGEN]) == tg, bar);
            __builtin_amdgcn_fence(__ATOMIC_ACQUIRE, "agent");
            xb_add(&bar[XB_XGEN(b.x)], 1u);
            asm volatile("s_waitcnt vmcnt(0)" ::: "memory");
        } else {
            XB_SPIN(xb_ld(&bar[XB_XGEN(b.x)]) == gen, bar);
            __builtin_amdgcn_fence(__ATOMIC_ACQUIRE, "agent");
            asm volatile("s_waitcnt vmcnt(0)" ::: "memory");
        }
    }
    __syncthreads();
}

namespace pg8 {
constexpr int BM = 256, BK = 64, HALF = 128, HTB = HALF * BK * 2, STAGE_BYTES = 8 * HTB, NXCD = 8, WGM = 8;
__host__ __device__ __forceinline__ int lds_byte(int r, int c) { const int st = (r >> 4) * 2 + (c >> 5), rr = r & 15, cc = c & 31, ob = rr * 64 + cc * 2; return st * 1024 + (ob ^ (((ob >> 9) & 1) << 5)); }
__host__ __device__ __forceinline__ void stage_rc(int b, int& R, int& C) { const int st = b / 1024, sb = b % 1024, swz = sb ^ (((sb >> 9) & 1) << 5); R = (st >> 1) * 16 + swz / 64; C = (st & 1) * 32 + (swz % 64) / 2; }
__host__ __device__ __forceinline__ int perm32(int rho) { const int n = rho >> 4, i = rho & 15; return 8 * (i >> 2) + 4 * n + (i & 3); }

struct Unit { int pm, pn, kt0, nt, sp; };
struct Gemm { const bf16* A; const bf16* Bt; int lda, ldb, K; };

struct StaticOrder {
    int nM, nN, nwg, G, c, ntk, wgm;
    __host__ __device__ void init(int M, int N, int G_, int c_) { nM = M / BM; nN = N / BM; nwg = nM * nN; G = G_; c = c_; ntk = 0; wgm = WGM; }
    __host__ __device__ bool next(int i, Unit& u) const {
        const long L = (long)i * G + c; if (L >= nwg) return false;
        int wgid = (int)L; { const int q = nwg / NXCD, r = nwg % NXCD, xcd = wgid % NXCD, off = wgid / NXCD; wgid = (xcd < r ? xcd * (q + 1) : r * (q + 1) + (xcd - r) * q) + off; }
        const int nig = wgm * nN, gid = wgid / nig, fm = gid * wgm, gsz = (nM - fm) < wgm ? (nM - fm) : wgm;
        u.pm = fm + ((wgid % nig) % gsz); u.pn = (wgid % nig) / gsz; u.kt0 = 0; u.nt = ntk; u.sp = 0; return true;
    }
};
struct TailSplitOrder {
    StaticOrder lat; int G, c, ntk, ctx;
    __host__ __device__ void init(int K, int G_, int c_, int ctx_, int wgm_ = WGM) { lat.init(64 * BM, 8 * BM, G_, c_); lat.ntk = K / BK; lat.wgm = wgm_; G = G_; c = c_; ntk = K / BK; ctx = ctx_; }
    __host__ __device__ bool next(int i, Unit& u) const {
        const bool stag = ctx && G == 256 && (c & 1);
        long L2;
        if (stag) { if (i > 0) return lat.next(i - 1, u); L2 = c; }
        else { if (lat.next(i, u)) return true; if (!ctx) return false; L2 = (long)i * G + c - 512; }
        if (L2 < 0 || L2 >= 256) return false;
        const int cu = (int)L2 >> 3, sp = (int)L2 & 7, np = ntk >> 1;
        const int p0 = (sp * np) >> 3, p1 = ((sp + 1) * np) >> 3;
        u.pm = 64 + (cu & 3); u.pn = cu >> 2; u.kt0 = 2 * p0; u.nt = 2 * (p1 - p0); u.sp = sp; return true;
    }
};

__device__ __forceinline__ unsigned cvt_pk_bf16(float lo, float hi) { unsigned r; asm volatile("v_cvt_pk_bf16_f32 %0, %1, %2" : "=v"(r) : "v"(lo), "v"(hi)); return r; }

template <class Epi, class Sched>
__device__ __forceinline__ void gemm_phase(LAS unsigned char* lds, const int tid, const Gemm g, const Sched& S, const Epi& E) {
    const int wid = __builtin_amdgcn_readfirstlane(tid >> 6), lane = tid & 63, wr = wid >> 2, wc = wid & 3, fr = lane & 15, fq = lane >> 4;
    unsigned voffA[2], voffB[2];
#pragma unroll
    for (int i = 0; i < 2; ++i) { int R, C; stage_rc(tid * 16 + i * 8192, R, C); const int Rb = Epi::PERM ? ((R & ~31) + perm32(R & 31)) : R;
        voffA[i] = (unsigned)(R * g.lda + C) * 2u; voffB[i] = (unsigned)(Rb * g.ldb + C) * 2u; }
    const size_t kstep = (size_t)(BK * 2);
    const size_t hstepA = (size_t)HALF * g.lda * 2, hstepB = (size_t)HALF * g.ldb * 2;
    const size_t tstepA = 2 * hstepA, tstepB = 2 * hstepB;
    const unsigned ldsw = (unsigned)wid * 1024u;
    const int aoff = lds_byte(wr * 64 + fr, fq * 8), boff = lds_byte(wc * 32 + fr, fq * 8);
#define PG8_SA(b, h) (((b) * 2 + (h)) * HTB)
#define PG8_SB(b, h) ((4 + (b) * 2 + (h)) * HTB)
#define PG8_STAGE(bufoff, gbase, voff) do { _Pragma("unroll") for (int _i = 0; _i < 2; ++_i) \
        __builtin_amdgcn_global_load_lds((const unsigned*)((const char*)(gbase) + (voff)[_i]), (LAS unsigned*)(lds + (bufoff) + ldsw + _i * 8192), 16, 0, 0); } while (0)
#define PG8_LDA(dst, b, h) do { _Pragma("unroll") for (int m = 0; m < 4; ++m) _Pragma("unroll") for (int k = 0; k < 2; ++k) dst[m][k] = *(const LAS bf16x8*)(lds + PG8_SA(b, h) + aoff + m * 2048 + k * 1024); } while (0)
#define PG8_LDB(dst, b, h) do { _Pragma("unroll") for (int n = 0; n < 2; ++n) _Pragma("unroll") for (int k = 0; k < 2; ++k) dst[n][k] = *(const LAS bf16x8*)(lds + PG8_SB(b, h) + boff + n * 2048 + k * 1024); } while (0)
#define PG8_MMA(ai, bj, At, Bt) do { __builtin_amdgcn_s_setprio(1); _Pragma("unroll") for (int m = 0; m < 4; ++m) _Pragma("unroll") for (int n = 0; n < 2; ++n) _Pragma("unroll") for (int k = 0; k < 2; ++k) \
        acc[ai][bj][m][n] = __builtin_amdgcn_mfma_f32_16x16x32_bf16(Bt[n][k], At[m][k], acc[ai][bj][m][n], 0, 0, 0); __builtin_amdgcn_s_setprio(0); } while (0)
#define PG8_WAIT_V(n) asm volatile("s_waitcnt vmcnt(" #n ")" ::: "memory")
#define PG8_WAIT_L(n) asm volatile("s_waitcnt lgkmcnt(" #n ")" ::: "memory")
#define PG8_BAR __builtin_amdgcn_s_barrier()
#define PG8_SCHED __builtin_amdgcn_sched_barrier(0)
    Unit cur, nxt; int ui = 0;
    if (!S.next(0, cur)) return;
    f32x4 acc[2][2][4][2];
#pragma unroll
    for (int a = 0; a < 2; ++a)
#pragma unroll
        for (int b = 0; b < 2; ++b)
#pragma unroll
            for (int m = 0; m < 4; ++m)
#pragma unroll
                for (int n = 0; n < 2; ++n) acc[a][b][m][n] = (f32x4){0.f, 0.f, 0.f, 0.f};
    bf16x8 At[4][2], B0[2][2], B1[2][2];
    const char* cA = (const char*)g.A + (size_t)cur.pm * tstepA + (size_t)cur.kt0 * kstep; const char* cB = (const char*)g.Bt + (size_t)cur.pn * tstepB + (size_t)cur.kt0 * kstep;
    PG8_STAGE(PG8_SB(0, 0), cB, voffB); PG8_STAGE(PG8_SB(0, 1), cB + hstepB, voffB); PG8_STAGE(PG8_SA(0, 0), cA, voffA); PG8_STAGE(PG8_SA(0, 1), cA + hstepA, voffA);
    if (wr == 1) PG8_BAR;
    PG8_WAIT_V(2); PG8_BAR;
    PG8_STAGE(PG8_SB(1, 0), cB + kstep, voffB); PG8_STAGE(PG8_SA(1, 0), cA + kstep, voffA); PG8_STAGE(PG8_SB(1, 1), cB + hstepB + kstep, voffB);
    PG8_WAIT_V(6); PG8_BAR;
    for (;;) {
        const bool has_next = S.next(ui + 1, nxt);
        const char* nA = has_next ? (const char*)g.A + (size_t)nxt.pm * tstepA + (size_t)nxt.kt0 * kstep : cA; const char* nB = has_next ? (const char*)g.Bt + (size_t)nxt.pn * tstepB + (size_t)nxt.kt0 * kstep : cB;
        const int nt = cur.nt;
        for (int t = 0; t < nt; t += 2) {
            const bool last = (t == nt - 2);
            const char* a1 = cA + (size_t)(t + 1) * kstep;
            const char* a2 = last ? nA : cA + (size_t)(t + 2) * kstep; const char* b2 = last ? nB : cB + (size_t)(t + 2) * kstep;
            const char* a3 = a2 + kstep; const char* b3 = b2 + kstep;
            PG8_LDB(B0, 0, 0); PG8_LDB(B1, 0, 1); PG8_SCHED; PG8_LDA(At, 0, 0); PG8_STAGE(PG8_SA(1, 1), a1 + hstepA, voffA);
            PG8_WAIT_V(8); PG8_WAIT_L(0); PG8_BAR; PG8_MMA(0, 0, At, B0); PG8_MMA(0, 1, At, B1); PG8_BAR; PG8_SCHED;
            PG8_LDA(At, 0, 1); PG8_STAGE(PG8_SB(0, 0), b2, voffB); PG8_STAGE(PG8_SB(0, 1), b2 + hstepB, voffB); PG8_STAGE(PG8_SA(0, 0), a2, voffA);
            PG8_WAIT_V(8); PG8_WAIT_L(0); PG8_BAR; PG8_MMA(1, 0, At, B0); PG8_MMA(1, 1, At, B1); PG8_BAR; PG8_SCHED;
            PG8_LDB(B0, 1, 0); PG8_LDB(B1, 1, 1); PG8_SCHED; PG8_LDA(At, 1, 0); PG8_STAGE(PG8_SA(0, 1), a2 + hstepA, voffA);
            PG8_WAIT_V(8); PG8_WAIT_L(0); PG8_BAR; PG8_MMA(0, 0, At, B0); PG8_MMA(0, 1, At, B1); PG8_BAR; PG8_SCHED;
            PG8_LDA(At, 1, 1); PG8_STAGE(PG8_SB(1, 0), b3, voffB); PG8_STAGE(PG8_SB(1, 1), b3 + hstepB, voffB); PG8_STAGE(PG8_SA(1, 0), a3, voffA);
            PG8_WAIT_V(8); PG8_WAIT_L(0); PG8_BAR; PG8_MMA(1, 0, At, B0); PG8_MMA(1, 1, At, B1); PG8_BAR; PG8_SCHED;
        }
        if (wr == 0) PG8_BAR;
        E(acc, cur, wr, wc, fr, fq);
        if (!has_next) break;
#pragma unroll
        for (int a = 0; a < 2; ++a)
#pragma unroll
            for (int b = 0; b < 2; ++b)
#pragma unroll
                for (int m = 0; m < 4; ++m)
#pragma unroll
                    for (int n = 0; n < 2; ++n) acc[a][b][m][n] = (f32x4){0.f, 0.f, 0.f, 0.f};
        cur = nxt; cA = nA; cB = nB; ++ui;
        if (wr == 1) PG8_BAR;
    }
    PG8_WAIT_V(0);
    PG8_BAR;
#undef PG8_SA
#undef PG8_SB
#undef PG8_STAGE
#undef PG8_LDA
#undef PG8_LDB
#undef PG8_MMA
#undef PG8_WAIT_V
#undef PG8_WAIT_L
#undef PG8_BAR
#undef PG8_SCHED
}

__device__ __forceinline__ float silu_fast(float x) { return x * __builtin_amdgcn_rcpf(1.f + __builtin_amdgcn_exp2f(-x * 1.4426950408889634f)); }

struct EpiSwiGLU {
    static constexpr bool PERM = true;
    bf16* O; int ldc;
    __device__ __forceinline__ void operator()(const f32x4 (&acc)[2][2][4][2], const Unit& u, int wr, int wc, int fr, int fq) const {
        const int row0 = u.pm * BM + wr * 64 + fr, col0 = u.pn * HALF + wc * 32 + 8 * fq;
#pragma unroll
        for (int ai = 0; ai < 2; ++ai)
#pragma unroll
            for (int m = 0; m < 4; ++m) {
                bf16* rowp = O + (size_t)(row0 + ai * HALF + m * 16) * ldc + col0;
                const f32x4 g0 = acc[ai][0][m][0], g1 = acc[ai][0][m][1], u0 = acc[ai][1][m][0], u1 = acc[ai][1][m][1];
                f32x4 e0 = g0 * -1.4426950408889634f, e1 = g1 * -1.4426950408889634f;
#pragma unroll
                for (int q = 0; q < 4; ++q) { e0[q] = __builtin_amdgcn_exp2f(e0[q]); e1[q] = __builtin_amdgcn_exp2f(e1[q]); }
                e0 = e0 + 1.f; e1 = e1 + 1.f;
#pragma unroll
                for (int q = 0; q < 4; ++q) { e0[q] = __builtin_amdgcn_rcpf(e0[q]); e1[q] = __builtin_amdgcn_rcpf(e1[q]); }
                const f32x4 r0 = (g0 * u0) * e0, r1 = (g1 * u1) * e1;
                u32x4 w;
                w.x = cvt_pk_bf16(r0[0], r0[1]); w.y = cvt_pk_bf16(r0[2], r0[3]); w.z = cvt_pk_bf16(r1[0], r1[1]); w.w = cvt_pk_bf16(r1[2], r1[3]);
                *(u32x4*)rowp = w;
            }
    }
};
struct EpiResid {
    static constexpr bool PERM = true;
    bf16* H; const float* modl; int gidx; float coef; int ntk; bf16* part;
    __device__ __forceinline__ void operator()(const f32x4 (&acc)[2][2][4][2], const Unit& u, int wr, int wc, int fr, int fq) const {
        const int row0 = u.pm * BM + wr * 64 + fr, colt = u.pn * BM + wc * 32 + 8 * fq;
        if (u.nt != ntk) {
            bf16* pp = part + ((size_t)u.sp * MC + (row0 - ML)) * D + colt;
#pragma unroll
            for (int ai = 0; ai < 2; ++ai)
#pragma unroll
                for (int m = 0; m < 4; ++m)
#pragma unroll
                    for (int bj = 0; bj < 2; ++bj) { const f32x4 a0 = acc[ai][bj][m][0], a1 = acc[ai][bj][m][1];
                        u32x4 w; w.x = cvt_pk_bf16(a0[0], a0[1]); w.y = cvt_pk_bf16(a0[2], a0[3]); w.z = cvt_pk_bf16(a1[0], a1[1]); w.w = cvt_pk_bf16(a1[2], a1[3]);
                        *(u32x4*)(pp + (size_t)(ai * HALF + m * 16) * D + bj * HALF) = w; }
            return;
        }
        const int bid = u.pm < 64 ? (u.pm >> 4) : 4;
        const float* gate = modl + (size_t)bid * NMODV + gidx * 2048 + colt;
        f32x4 gv[2][2];
#pragma unroll
        for (int bj = 0; bj < 2; ++bj)
#pragma unroll
            for (int n = 0; n < 2; ++n) gv[bj][n] = *(const f32x4*)(gate + bj * HALF + 4 * n);
#pragma unroll
        for (int ai = 0; ai < 2; ++ai) {
            u32x4 hw[4][2];
#pragma unroll
            for (int m = 0; m < 4; ++m) { const bf16* rowp = H + (size_t)(row0 + ai * HALF + m * 16) * D + colt;
#pragma unroll
                for (int bj = 0; bj < 2; ++bj) hw[m][bj] = *(const u32x4*)(rowp + bj * HALF); }
            if (ai == 0) {
#pragma unroll
                for (int bj = 0; bj < 2; ++bj)
#pragma unroll
                    for (int n = 0; n < 2; ++n) gv[bj][n] = gv[bj][n] * coef;
            }
#pragma unroll
            for (int m = 0; m < 4; ++m) { bf16* rowp = H + (size_t)(row0 + ai * HALF + m * 16) * D + colt;
#pragma unroll
                for (int bj = 0; bj < 2; ++bj) { const u32x4 h4 = hw[m][bj];
                    const f32x4 v0 = (f32x4){bflo(h4.x), bfhi(h4.x), bflo(h4.y), bfhi(h4.y)} + gv[bj][0] * acc[ai][bj][m][0];
                    const f32x4 v1 = (f32x4){bflo(h4.z), bfhi(h4.z), bflo(h4.w), bfhi(h4.w)} + gv[bj][1] * acc[ai][bj][m][1];
                    u32x4 o; o.x = cvt_pk_bf16(v0[0], v0[1]); o.y = cvt_pk_bf16(v0[2], v0[3]); o.z = cvt_pk_bf16(v1[0], v1[1]); o.w = cvt_pk_bf16(v1[2], v1[3]);
                    *(u32x4*)(rowp + bj * HALF) = o; } }
        }
    }
};
struct EpiBf16 {
    static constexpr bool PERM = true;
    bf16* O; int ldc; const float* rs; const float* cs; int remap;
    __device__ __forceinline__ void operator()(const f32x4 (&acc)[2][2][4][2], const Unit& u, int wr, int wc, int fr, int fq) const {
        const int row0 = u.pm * BM + wr * 64 + fr, colt = u.pn * BM + wc * 32 + 8 * fq;
        float sr[2][4]; f32x4 cc[2][2];
#pragma unroll
        for (int ai = 0; ai < 2; ++ai)
#pragma unroll
            for (int m = 0; m < 4; ++m) sr[ai][m] = rs ? rs[row0 + ai * HALF + m * 16] : 1.f;
#pragma unroll
        for (int bj = 0; bj < 2; ++bj) { const int c = colt + bj * HALF; cc[bj][0] = (f32x4){1.f, 1.f, 1.f, 1.f}; cc[bj][1] = cc[bj][0];
            if (cs) { cc[bj][0] = *(const f32x4*)(cs + c); cc[bj][1] = *(const f32x4*)(cs + c + 4); } }
#pragma unroll
        for (int bj = 0; bj < 2; ++bj) {
            const int c = colt + bj * HALF, oc = remap ? ((c >> 6) * 96 + (c & 63)) : c;
            const f32x4 c0 = cc[bj][0], c1 = cc[bj][1];
#pragma unroll
            for (int ai = 0; ai < 2; ++ai)
#pragma unroll
                for (int m = 0; m < 4; ++m) { const int r = row0 + ai * HALF + m * 16; const float s = sr[ai][m];
                    const f32x4 v0 = acc[ai][bj][m][0] * c0 * s, v1 = acc[ai][bj][m][1] * c1 * s;
                    u32x4 w; w.x = cvt_pk_bf16(v0[0], v0[1]); w.y = cvt_pk_bf16(v0[2], v0[3]); w.z = cvt_pk_bf16(v1[0], v1[1]); w.w = cvt_pk_bf16(v1[2], v1[3]);
                    *(u32x4*)(O + (size_t)r * ldc + oc) = w; }
        }
    }
};
}

struct Frame {
    LAS unsigned char* lds;
    int tid, lane, wave, vcu, G;
    unsigned char* ws; float* out;
};
__device__ __forceinline__ Frame fresh(const Frame& F0) {
    Frame F = F0;
    asm volatile("" : "+v"(F.tid), "+v"(F.lane));
    asm volatile("" : "+s"(F.wave), "+s"(F.vcu), "+s"(F.G));
    asm volatile("" : "+s"(F.ws), "+s"(F.out));
    F.ws = (unsigned char*)(GAS unsigned char*)(unsigned long long)F.ws; F.out = (float*)(GAS float*)(unsigned long long)F.out;
    return F;
}
constexpr int PTAB_OFF = LDSCTL_OFF + 1024;
__device__ __forceinline__ const float* inp_ptr(const Frame& F, int i) {
    const LAS unsigned* p = (const LAS unsigned*)(F.lds + PTAB_OFF) + 2 * i;
    const unsigned lo = __builtin_amdgcn_readfirstlane(p[0]), hi = __builtin_amdgcn_readfirstlane(p[1]);
    return (const float*)(const GAS float*)(((unsigned long long)hi << 32) | lo);
}
#define INP(i) inp_ptr(F, (i))
enum { I_X = 0, I_C, I_CTX, I_CCTX, I_WMOD, I_BMOD, I_NORMG, I_WGATE, I_WUP, I_WDOWN, I_WIN, I_WOUT, I_CONVW, I_CONVB, I_DTB, I_ALOG, I_DSKIP, I_SSDN,
       I_QNORM, I_WUQ, I_KVNORM, I_WUKV, I_MLAON, I_SINK, I_SWAON, I_FNORM };

struct RowMap { bf16* b0; bf16* b1; int mode; int ldd; };
__device__ __forceinline__ bf16* rowmap(const RowMap& r, int n) {
    if (r.mode == 0) return r.b0 + (size_t)n * r.ldd;
    if (r.mode == 1) return r.b0 + (size_t)((n >> 7) * 256 + (n & 127)) * r.ldd;
    if (r.mode == 2) return r.b0 + (size_t)((n >> 7) * 256 + 128 + (n & 127)) * r.ldd;
    const int h = n >> 7, j = n & 127;
    return j < 64 ? r.b0 + (size_t)(h * 64 + j) * r.ldd : r.b1 + (size_t)(h * 64 + j - 64) * r.ldd;
}
__device__ __forceinline__ void cvt_item(const float* W, int N, int nblk, int item, const RowMap& rm, const float* ksc, LAS float* scr, int lane) {
    const int kb = item / nblk, nb = item % nblk, k0 = 64 * kb, n0 = 32 * nb;
    {
        float v[32];
#pragma unroll
        for (int i = 0; i < 32; ++i) v[i] = __builtin_nontemporal_load(&W[(size_t)(k0 + 2 * i + (lane >> 5)) * N + n0 + (lane & 31)]);
        if (ksc) {
            float kv[32];
#pragma unroll
            for (int i = 0; i < 32; ++i) kv[i] = ksc[k0 + 2 * i + (lane >> 5)];
#pragma unroll
            for (int i = 0; i < 32; ++i) v[i] *= kv[i];
        }
#pragma unroll
        for (int i = 0; i < 32; ++i) scr[(2 * i + (lane >> 5)) * 33 + (lane & 31)] = v[i];
    }
    LDS_WAIT(); asm volatile("" ::: "memory");
    const int c = lane & 7;
#pragma unroll
    for (int j = 0; j < 4; ++j) { const int n = (lane >> 3) + 8 * j; const LAS float* s = scr + (8 * c) * 33 + n;
        u32x4 o; o.x = pk2(s[0 * 33], s[1 * 33]); o.y = pk2(s[2 * 33], s[3 * 33]); o.z = pk2(s[4 * 33], s[5 * 33]); o.w = pk2(s[6 * 33], s[7 * 33]);
        __builtin_nontemporal_store(o, (u32x4*)(rowmap(rm, n0 + n) + k0 + 8 * c)); }
    LDS_WAIT(); asm volatile("" ::: "memory");
}
__device__ __forceinline__ void cvt_load(const float* W, int N, int nblk, int item, float (&v)[32], int lane) {
    const int kb = item / nblk, nb = item % nblk, k0 = 64 * kb, n0 = 32 * nb;
#pragma unroll
    for (int i = 0; i < 32; ++i) v[i] = __builtin_nontemporal_load(&W[(size_t)(k0 + 2 * i + (lane >> 5)) * N + n0 + (lane & 31)]);
}
__device__ __forceinline__ void cvt_finish(const float (&v)[32], int nblk, int item, const RowMap& rm, LAS float* scr, int lane) {
    const int kb = item / nblk, nb = item % nblk, k0 = 64 * kb, n0 = 32 * nb;
#pragma unroll
    for (int i = 0; i < 32; ++i) scr[(2 * i + (lane >> 5)) * 33 + (lane & 31)] = v[i];
    LDS_WAIT(); asm volatile("" ::: "memory");
    const int c = lane & 7;
#pragma unroll
    for (int j = 0; j < 4; ++j) { const int n = (lane >> 3) + 8 * j; const LAS float* s = scr + (8 * c) * 33 + n;
        u32x4 o; o.x = pk2(s[0 * 33], s[1 * 33]); o.y = pk2(s[2 * 33], s[3 * 33]); o.z = pk2(s[4 * 33], s[5 * 33]); o.w = pk2(s[6 * 33], s[7 * 33]);
        __builtin_nontemporal_store(o, (u32x4*)(rowmap(rm, n0 + n) + k0 + 8 * c)); }
    LDS_WAIT(); asm volatile("" ::: "memory");
}
__device__ __forceinline__ void bg_convert(const Frame& F, int kind, int lf, int rank, int nidle) {
    LAS float* scr = (LAS float*)(F.lds + F.wave * 16384);
    constexpr int I_GU = 32 * 176, I_DN = 88 * 64, I_INW = 32 * 126, I_OUTW = 32 * 64;
    const bool gu = (kind == 0 || kind >= 3);
    const int nit = kind == 0 ? 2 * I_GU : kind == 1 ? I_DN : kind == 2 ? I_INW + I_OUTW : I_GU, nw = nidle * NWAVES;
#define BG_DESC(it_) const int up_ = (kind == 0 && (it_) >= I_GU) || (kind == 2 && (it_) >= I_INW) || kind == 4; \
        const int r_ = kind == 0 ? (up_ ? (it_) - I_GU : (it_)) : kind == 2 ? (up_ ? (it_) - I_INW : (it_)) : (it_); \
        const float* W_ = gu ? (up_ ? INP(I_WUP) : INP(I_WGATE)) + (size_t)lf * D * DFF : kind == 1 ? INP(I_WDOWN) + (size_t)lf * DFF * D : up_ ? INP(I_WOUT) + (size_t)lf * D * D : INP(I_WIN) + (size_t)lf * D * DIN; \
        const int N_ = gu ? DFF : kind == 1 ? D : up_ ? D : DIN, nblk_ = gu ? 176 : kind == 1 ? 64 : up_ ? 64 : 126;
    int it = rank * NWAVES + F.wave;
    float cur[32];
    if (it < nit) { BG_DESC(it) cvt_load(W_, N_, nblk_, r_, cur, F.lane); }
    for (; it < nit; it += nw) {
        const int itn = (it + nw < nit) ? it + nw : it;
        float nx[32];
        { BG_DESC(itn) cvt_load(W_, N_, nblk_, r_, nx, F.lane); }
        { BG_DESC(it)
          const RowMap rm = gu ? RowMap{((bf16*)(F.ws + WS_WGU)) + (size_t)lf * 11264 * D, nullptr, up_ ? 2 : 1, D}
                          : kind == 1 ? RowMap{((bf16*)(F.ws + WS_WD)) + (size_t)lf * D * DFF, nullptr, 0, DFF}
                          : up_ ? RowMap{((bf16*)(F.ws + WS_WOUT)) + (size_t)lf * D * D, nullptr, 0, D} : RowMap{((bf16*)(F.ws + WS_WIN)) + (size_t)lf * DINP * D, nullptr, 0, D};
          (void)W_; (void)N_;
          cvt_finish(cur, nblk_, r_, rm, scr, F.lane); }
#pragma unroll
        for (int i = 0; i < 32; ++i) cur[i] = nx[i];
    }
#undef BG_DESC
}
__device__ __forceinline__ bool bg_deferred_gu(int lf) { return lf >= 1; }
__device__ __forceinline__ bool bg_deferred_dn(int lf) { return lf >= 1; }
__device__ __forceinline__ void ph_prologue(const Frame& F) {
    const size_t gtid = (size_t)F.vcu * 512 + F.tid, gth = (size_t)F.G * 512;
    {
        const f32x4* x4 = (const f32x4*)INP(I_X); const f32x4* c4 = (const f32x4*)INP(I_CTX); u32x2* h2 = (u32x2*)(F.ws + WS_H);
        const size_t nx = (size_t)ML * D / 4, nc = (size_t)MC * D / 4;
        const size_t tot = nx + nc;
        for (size_t i0 = gtid; i0 < tot; i0 += 8 * gth) {
            f32x4 v[8];
#pragma unroll
            for (int u = 0; u < 8; ++u) { const size_t i = i0 + u * gth, ic = i < tot ? i : tot - 1; const f32x4* src = ic < nx ? x4 + ic : c4 + (ic - nx); v[u] = __builtin_nontemporal_load(src); }
#pragma unroll
            for (int u = 0; u < 8; ++u) { const size_t i = i0 + u * gth; if (i < tot) { u32x2 w; w.x = pk2(v[u].x, v[u].y); w.y = pk2(v[u].z, v[u].w); h2[i] = w; } }
        }
    }
    for (size_t i = gtid; i < (size_t)DEPTH * 16384; i += gth) {
        const size_t l = i / 16384, r = i % 16384; ((u32x4*)(((bf16*)(F.ws + WS_WIN)) + (l * DINP + DIN) * D))[r] = (u32x4){0u, 0u, 0u, 0u};
    }
    LAS float* scr = (LAS float*)(F.lds + F.wave * 16384);
    const int gw = F.vcu * NWAVES + F.wave, NGW = F.G * NWAVES;
    constexpr int I_GU = 32 * 176, I_DN = 88 * 64, I_INW = 32 * 126, I_OUTW = 32 * 64, I_UQ = 6 * 24, I_UKV = 4 * 32;
    constexpr int N_A = 8 * I_GU, N_B = 8 * I_GU, N_C = 8 * I_DN, N_D = 4 * I_INW, N_E = 4 * I_OUTW, N_F = 4 * I_UQ, N_G = 4 * I_UKV;
    constexpr int NITEMS = N_A + N_B + N_C + N_D + N_E + N_F + N_G;
    for (int it = gw; it < NITEMS; it += NGW) {
        int r = it;
        if (r < N_A) { const int lf = r / I_GU; if (bg_deferred_gu(lf)) continue; RowMap rm{((bf16*)(F.ws + WS_WGU)) + (size_t)lf * 11264 * D, nullptr, 1, D}; cvt_item(INP(I_WGATE) + (size_t)lf * D * DFF, DFF, 176, r % I_GU, rm, nullptr, scr, F.lane); continue; } r -= N_A;
        if (r < N_B) { const int lf = r / I_GU; if (bg_deferred_gu(lf)) continue; RowMap rm{((bf16*)(F.ws + WS_WGU)) + (size_t)lf * 11264 * D, nullptr, 2, D}; cvt_item(INP(I_WUP) + (size_t)lf * D * DFF, DFF, 176, r % I_GU, rm, nullptr, scr, F.lane); continue; } r -= N_B;
        if (r < N_C) { const int lf = r / I_DN; if (bg_deferred_dn(lf)) continue; RowMap rm{((bf16*)(F.ws + WS_WD)) + (size_t)lf * D * DFF, nullptr, 0, DFF}; cvt_item(INP(I_WDOWN) + (size_t)lf * DFF * D, D, 64, r % I_DN, rm, nullptr, scr, F.lane); continue; } r -= N_C;
        if (r < N_D) { const int l = r / I_INW; if (l >= 1) continue; RowMap rm{((bf16*)(F.ws + WS_WIN)) + (size_t)l * DINP * D, nullptr, 0, D}; cvt_item(INP(I_WIN) + (size_t)l * D * DIN, DIN, 126, r % I_INW, rm, nullptr, scr, F.lane); continue; } r -= N_D;
        if (r < N_E) { const int l = r / I_OUTW; if (l >= 1) continue; RowMap rm{((bf16*)(F.ws + WS_WOUT)) + (size_t)l * D * D, nullptr, 0, D}; cvt_item(INP(I_WOUT) + (size_t)l * D * D, D, 64, r % I_OUTW, rm, nullptr, scr, F.lane); continue; } r -= N_E;
        if (r < N_F) { const int l = r / I_UQ; RowMap rm{((bf16*)(F.ws + WS_WUQ)) + (size_t)l * 768 * 384, nullptr, 0, 384}; cvt_item(INP(I_WUQ) + (size_t)l * 384 * 768, 768, 24, r % I_UQ, rm, INP(I_QNORM) + l * 384, scr, F.lane); continue; } r -= N_F;
        { const int l = r / I_UKV; RowMap rm{((bf16*)(F.ws + WS_WUK)) + (size_t)l * 512 * 256, ((bf16*)(F.ws + WS_WUV)) + (size_t)l * 512 * 256, 3, 256}; cvt_item(INP(I_WUKV) + (size_t)l * 256 * 1024, 1024, 32, r % I_UKV, rm, INP(I_KVNORM) + l * 256, scr, F.lane); }
    }
    __syncthreads();
    LAS float* sv = (LAS float*)F.lds;
    for (int i = F.tid; i < 5 * D; i += 512) { const int r = i / D, k = i % D; const float c = r < 4 ? INP(I_C)[r * D + k] : INP(I_CCTX)[k]; sv[i] = silu_f(c); }
    __syncthreads();
    {
        const int per = (2304 + F.G - 1) / F.G, it0 = F.vcu * per, it1 = (it0 + per < 2304) ? it0 + per : 2304;
        f32x4 a0 = {0.f, 0.f, 0.f, 0.f}, a1 = a0, a2 = a0, a3 = a0, a4 = a0;
        for (int it = it0; it < it1; ++it) {
            const int B = it >> 6, kc = it & 63, l = B / 9, nc = B % 9;
            const float* w = INP(I_WMOD) + (size_t)l * D * NMODV + nc * 2048 + 4 * F.tid + (size_t)(kc * 32) * NMODV;
#pragma unroll
            for (int kb = 0; kb < 32; kb += 8) {
                f32x4 wv[8];
#pragma unroll
                for (int u = 0; u < 8; ++u) wv[u] = __builtin_nontemporal_load((const f32x4*)(w + (size_t)(kb + u) * NMODV));
#pragma unroll
                for (int u = 0; u < 8; ++u) { const int k = kc * 32 + kb + u; a0 += wv[u] * sv[k]; a1 += wv[u] * sv[D + k]; a2 += wv[u] * sv[2 * D + k]; a3 += wv[u] * sv[3 * D + k]; a4 += wv[u] * sv[4 * D + k]; }
            }
            if (it + 1 == it1 || ((it + 1) >> 6) != B) {
                const int piece = F.vcu - (64 * B) / per;
                float* o = ((float*)(F.ws + WS_HID)) + ((size_t)(B * 16 + piece) * 5) * 2048 + 4 * F.tid;
                *(f32x4*)(o) = a0; *(f32x4*)(o + 2048) = a1; *(f32x4*)(o + 2 * 2048) = a2; *(f32x4*)(o + 3 * 2048) = a3; *(f32x4*)(o + 4 * 2048) = a4;
                a0 = (f32x4){0.f, 0.f, 0.f, 0.f}; a1 = a0; a2 = a0; a3 = a0; a4 = a0;
            }
        }
    }
}
__device__ __forceinline__ void ph_modfinal(const Frame& F) {
    const size_t gtid = (size_t)F.vcu * 512 + F.tid, gth = (size_t)F.G * 512;
    const int per = (2304 + F.G - 1) / F.G;
    for (size_t i = gtid; i < (size_t)4 * 5 * NMODV; i += gth) {
        const int n = (int)(i % NMODV), lr = (int)(i / NMODV), l = lr / 5, r = lr % 5, B = l * 9 + (n >> 11);
        const int np = (64 * B + 63) / per - (64 * B) / per + 1;
        float s = INP(I_BMOD)[(size_t)l * NMODV + n];
        const float* pp = ((float*)(F.ws + WS_HID)) + ((size_t)(B * 16) * 5 + r) * 2048 + (n & 2047);
        float pv[16];
#pragma unroll
        for (int q = 0; q < 16; ++q) pv[q] = pp[(size_t)(q < np ? q : np - 1) * 5 * 2048];
#pragma unroll
        for (int q = 0; q < 16; ++q) s += q < np ? pv[q] : 0.f;
        ((float*)(F.ws + WS_MODV))[i] = s;
    }
}
__device__ __forceinline__ void ph_norm(const Frame& F, int l, int which, int pend_l, int pend_g, float pend_coef, int nrows) {
    const int gw = F.vcu * NWAVES + F.wave, NGW = F.G * NWAVES;
    LAS float* tab = (LAS float*)F.lds;
    {
        const float* g = INP(I_NORMG) + (size_t)(l * 3 + which) * D;
        for (int i = F.tid; i < 5 * (D / 4); i += 512) {
            const int bid = i / (D / 4), c = 4 * (i % (D / 4));
            const float* mv = ((float*)(F.ws + WS_MODV)) + ((size_t)l * 5 + bid) * NMODV + (size_t)(3 * which) * D;
            const f32x4 gg = *(const f32x4*)(g + c), sh = *(const f32x4*)(mv + c), sc = *(const f32x4*)(mv + D + c);
            *(LAS f32x4*)(tab + (bid * 2) * D + c) = gg * (sc + 1.f);
            *(LAS f32x4*)(tab + (bid * 2 + 1) * D + c) = sh;
        }
        __syncthreads();
    }
    u32x2 cur[8];
    { const u32x2* xr = (const u32x2*)(((bf16*)(F.ws + WS_H)) + (size_t)gw * D) + F.lane;
#pragma unroll
      for (int j = 0; j < 8; ++j) cur[j] = xr[64 * j]; }
    for (int m = gw; m < nrows; m += NGW) {
        const int mn = (m + NGW < nrows) ? m + NGW : m;
        u32x2 nx[8];
        { const u32x2* xn = (const u32x2*)(((bf16*)(F.ws + WS_H)) + (size_t)mn * D) + F.lane;
#pragma unroll
          for (int j = 0; j < 8; ++j) nx[j] = xn[64 * j]; }
        const int bid = m < ML ? (m >> 12) : 4;
        u32x2* xr = (u32x2*)(((bf16*)(F.ws + WS_H)) + (size_t)m * D) + F.lane;
        f32x4 v[8]; float s = 0.f;
#pragma unroll
        for (int j = 0; j < 8; ++j) { const u32x2 hw = cur[j]; v[j] = (f32x4){bflo(hw.x), bfhi(hw.x), bflo(hw.y), bfhi(hw.y)}; }
        if (m >= ML && pend_g >= 0) {
            const float* pg = ((float*)(F.ws + WS_MODV)) + ((size_t)pend_l * 5 + 4) * NMODV + (size_t)pend_g * D;
            const u32x2* pr = (const u32x2*)(((bf16*)(F.ws + WS_PART)) + (size_t)(m - ML) * D) + F.lane;
            u32x2 hws[8];
#pragma unroll
            for (int jj = 0; jj < 8; jj += 4) {
                u32x2 pw[4][8]; f32x4 gt[4];
#pragma unroll
                for (int jx = 0; jx < 4; ++jx) {
#pragma unroll
                    for (int sp = 0; sp < 8; ++sp) pw[jx][sp] = pr[(size_t)sp * MC * D / 4 + 64 * (jj + jx)];
                    gt[jx] = *(const f32x4*)(pg + 4 * F.lane + 256 * (jj + jx)); }
#pragma unroll
                for (int jx = 0; jx < 4; ++jx) { const int j = jj + jx; f32x4 a = {0.f, 0.f, 0.f, 0.f};
#pragma unroll
                    for (int sp = 0; sp < 8; ++sp) { const u32x2 w = pw[jx][sp]; a += (f32x4){bflo(w.x), bfhi(w.x), bflo(w.y), bfhi(w.y)}; }
                    v[j] += a * (gt[jx] * pend_coef);
                    u32x2 hw; hw.x = pk2(v[j].x, v[j].y); hw.y = pk2(v[j].z, v[j].w); hws[j] = hw;
                    v[j] = (f32x4){bflo(hw.x), bfhi(hw.x), bflo(hw.y), bfhi(hw.y)}; }
            }
#pragma unroll
            for (int j = 0; j < 8; ++j) xr[64 * j] = hws[j];
        }
#pragma unroll
        for (int j = 0; j < 8; ++j) s += (v[j].x * v[j].x + v[j].y * v[j].y) + (v[j].z * v[j].z + v[j].w * v[j].w);
        const float rstd = rsqrtf(wave_sum(s) * (1.f / D) + EPS);
        u32x2* o = (u32x2*)(((bf16*)(F.ws + WS_U)) + (size_t)m * D) + F.lane;
        const LAS float* ta = tab + (bid * 2) * D + 4 * F.lane;
#pragma unroll
        for (int j = 0; j < 8; ++j) {
            const f32x4 ga = *(const LAS f32x4*)(ta + 256 * j), sh = *(const LAS f32x4*)(ta + D + 256 * j);
            const f32x4 y = v[j] * rstd * ga + sh;
            u32x2 w; w.x = pk2(y.x, y.y); w.y = pk2(y.z, y.w); o[64 * j] = w;
        }
#pragma unroll
        for (int j = 0; j < 8; ++j) cur[j] = nx[j];
    }
}
__device__ __forceinline__ void ph_prep(const Frame& F, int l) {
    const int gw = F.vcu * NWAVES + F.wave, NGW = F.G * NWAVES, lane = F.lane;
    const bf16* P = ((bf16*)(F.ws + WS_P));
#define PR_LOAD(mm, Q0, Q1, KV, KR, KS0, KS1, VS0, VS1) do { const bf16* pr_ = P + (size_t)(mm) * DINP; \
        Q0 = *(const u32x2*)(pr_ + PC_CQ + 4 * lane); Q1 = *(const unsigned*)(pr_ + PC_CQ + 256 + 2 * lane); KV = *(const u32x2*)(pr_ + PC_CKV + 4 * lane); \
        KR = pr_[PC_KR + (lane & 31)]; KS0 = pr_[PC_KS + lane]; KS1 = pr_[PC_KS + 64 + lane]; VS0 = pr_[PC_VS + lane]; VS1 = pr_[PC_VS + 64 + lane]; } while (0)
    u32x2 cq0, nq0, ckv, nkv; unsigned cq1, nq1; bf16 ckr, nkr, cks0, nks0, cks1, nks1, cvs0, nvs0, cvs1, nvs1;
    PR_LOAD(gw, cq0, cq1, ckv, ckr, cks0, cks1, cvs0, cvs1);
    for (int m = gw; m < MT; m += NGW) {
        const int mn = (m + NGW < MT) ? m + NGW : m;
        int t, isl; if (m < ML) { t = m & 4095; isl = 1; } else { t = (m - ML) & 255; isl = 0; }
        float cs8, sn8, cs16, sn16;
        { const int pos8 = ((lane >> 4) & 1) ? (t & 63) : (t >> 6), pos16 = (lane >> 5) ? (t & 63) : (t >> 6);
          cs8 = ROPE_COS_8[pos8 * 8 + (lane & 7)]; sn8 = ROPE_SIN_8[pos8 * 8 + (lane & 7)]; cs16 = ROPE_COS_16[pos16 * 16 + (lane & 15)]; sn16 = ROPE_SIN_16[pos16 * 16 + (lane & 15)]; }
        PR_LOAD(mn, nq0, nq1, nkv, nkr, nks0, nks1, nvs0, nvs1);
        float sq = (bflo(cq0.x) * bflo(cq0.x) + bfhi(cq0.x) * bfhi(cq0.x)) + (bflo(cq0.y) * bflo(cq0.y) + bfhi(cq0.y) * bfhi(cq0.y)) + (bflo(cq1) * bflo(cq1) + bfhi(cq1) * bfhi(cq1));
        float sk = (bflo(ckv.x) * bflo(ckv.x) + bfhi(ckv.x) * bfhi(ckv.x)) + (bflo(ckv.y) * bflo(ckv.y) + bfhi(ckv.y) * bfhi(ckv.y));
        sq = wave_sum(sq); sk = wave_sum(sk);
        if (lane == 0) { ((float*)(F.ws + WS_RSTD))[m] = rsqrtf(sq * (1.f / 384.f) + EPS); ((float*)(F.ws + WS_RSTD))[MT + m] = rsqrtf(sk * (1.f / 256.f) + EPS); }
        {
            const float x = bf2f(ckr); const float px = __shfl_xor(x, 8); float o = x;
            if (isl) { const int idx = lane & 15; o = idx < 8 ? x * cs8 - px * sn8 : x * cs8 + px * sn8; }
            if (lane < 32) { const bf16 ob = (bf16)f2bf(o);
#pragma unroll
                for (int h = 0; h < 8; ++h) ((bf16*)(F.ws + WS_KM))[(size_t)m * 768 + h * 96 + 64 + lane] = ob; }
        }
#pragma unroll
        for (int gi = 0; gi < 2; ++gi) {
            const float x = bf2f(gi ? cks1 : cks0); const float px = __shfl_xor(x, 16); float o = x;
            if (isl) { const int idx = lane & 31; o = idx < 16 ? x * cs16 - px * sn16 : x * cs16 + px * sn16; }
            ((bf16*)(F.ws + WS_KS))[(size_t)m * 128 + gi * 64 + lane] = (bf16)f2bf(o);
            ((bf16*)(F.ws + WS_VST))[(size_t)(gi * 64 + lane) * MT + m] = gi ? cvs1 : cvs0;
        }
        cq0 = nq0; cq1 = nq1; ckv = nkv; ckr = nkr; cks0 = nks0; cks1 = nks1; cvs0 = nvs0; cvs1 = nvs1;
    }
#undef PR_LOAD
}
__device__ __forceinline__ void ph_outnorm(const Frame& F, int l) {
    const int gw = F.vcu * NWAVES + F.wave, NGW = F.G * NWAVES, lane = F.lane;
    const int nrows = l == DEPTH - 1 ? ML : MT;
    const float* gs = INP(I_SSDN) + l * 1024 + 4 * lane; const float* gm = INP(I_MLAON) + l * 512 + 4 * lane; const float* gq = INP(I_SWAON) + l * 512 + 4 * lane;
    f32x4 ggs[4], ggm[2], ggq[2];
#pragma unroll
    for (int j = 0; j < 4; ++j) ggs[j] = *(const f32x4*)(gs + 256 * j);
#pragma unroll
    for (int j = 0; j < 2; ++j) { ggm[j] = *(const f32x4*)(gm + 256 * j); ggq[j] = *(const f32x4*)(gq + 256 * j); }
#define ON_LOAD(mm, Y, A, B, Q) do { const u32x2* yg_ = (const u32x2*)(((bf16*)(F.ws + WS_YG)) + (size_t)(mm) * 1024) + lane; \
        const u32x2* mx_ = (const u32x2*)(((bf16*)(F.ws + WS_MX)) + (size_t)(mm) * 512) + lane; const u32x2* sx_ = (const u32x2*)(((bf16*)(F.ws + WS_SX)) + (size_t)(mm) * 512) + lane; \
        _Pragma("unroll") for (int j = 0; j < 4; ++j) Y[j] = yg_[64 * j]; \
        _Pragma("unroll") for (int j = 0; j < 2; ++j) { const u32x2 ma_ = mx_[64 * j], sb_ = sx_[64 * j]; A[j] = (f32x4){bflo(ma_.x), bfhi(ma_.x), bflo(ma_.y), bfhi(ma_.y)}; B[j] = (f32x4){bflo(sb_.x), bfhi(sb_.x), bflo(sb_.y), bfhi(sb_.y)}; } \
        Q = ((float*)(F.ws + WS_SSQ))[(size_t)(mm) * 16 + (lane & 15)]; } while (0)
    u32x2 y[4], ny[4]; f32x4 a[2], b[2], na[2], nb[2]; float qv, nq;
    ON_LOAD(gw, y, a, b, qv);
    for (int m = gw; m < nrows; m += NGW) {
        const int mn = (m + NGW < nrows) ? m + NGW : m;
        ON_LOAD(mn, ny, na, nb, nq);
        const float q = (lane < 16) ? qv : 0.f;
        float q0 = lane < 8 ? q : 0.f, q1 = lane >= 8 ? q : 0.f, sa = 0.f, sb = 0.f;
#pragma unroll
        for (int j = 0; j < 2; ++j) { sa += (a[j].x * a[j].x + a[j].y * a[j].y) + (a[j].z * a[j].z + a[j].w * a[j].w); sb += (b[j].x * b[j].x + b[j].y * b[j].y) + (b[j].z * b[j].z + b[j].w * b[j].w); }
        q0 = wave_sum(q0); q1 = wave_sum(q1); sa = wave_sum(sa); sb = wave_sum(sb);
        const float r0 = rsqrtf(q0 * (1.f / 512.f) + EPS), r1 = rsqrtf(q1 * (1.f / 512.f) + EPS), ra = rsqrtf(sa * (1.f / 512.f) + EPS), rb = rsqrtf(sb * (1.f / 512.f) + EPS);
        u32x2* o = (u32x2*)(((bf16*)(F.ws + WS_OX)) + (size_t)m * D) + lane;
#pragma unroll
        for (int j = 0; j < 4; ++j) { const f32x4 gg = ggs[j]; const float r = j < 2 ? r0 : r1;
            u32x2 w; w.x = pk2(bflo(y[j].x) * r * gg.x, bfhi(y[j].x) * r * gg.y); w.y = pk2(bflo(y[j].y) * r * gg.z, bfhi(y[j].y) * r * gg.w); o[64 * j] = w; }
#pragma unroll
        for (int j = 0; j < 2; ++j) { const f32x4 v = a[j] * ra * ggm[j]; u32x2 w; w.x = pk2(v.x, v.y); w.y = pk2(v.z, v.w); o[256 + 64 * j] = w; }
#pragma unroll
        for (int j = 0; j < 2; ++j) { const f32x4 v = b[j] * rb * ggq[j]; u32x2 w; w.x = pk2(v.x, v.y); w.y = pk2(v.z, v.w); o[384 + 64 * j] = w; }
#pragma unroll
        for (int j = 0; j < 4; ++j) y[j] = ny[j];
#pragma unroll
        for (int j = 0; j < 2; ++j) { a[j] = na[j]; b[j] = nb[j]; }
        qv = nq;
    }
#undef ON_LOAD
}
__device__ __forceinline__ void ph_final(const Frame& F) {
    const int gw = F.vcu * NWAVES + F.wave, NGW = F.G * NWAVES;
    const float* g = INP(I_FNORM);
    u32x2 cur[8];
    { const u32x2* xr = (const u32x2*)(((bf16*)(F.ws + WS_H)) + (size_t)gw * D) + F.lane;
#pragma unroll
      for (int j = 0; j < 8; ++j) cur[j] = xr[64 * j]; }
    f32x4 gg[8];
#pragma unroll
    for (int j = 0; j < 8; ++j) gg[j] = *(const f32x4*)(g + 4 * F.lane + 256 * j);
    for (int m = gw; m < ML; m += NGW) {
        const int mn = (m + NGW < ML) ? m + NGW : m;
        u32x2 nx[8];
        { const u32x2* xn = (const u32x2*)(((bf16*)(F.ws + WS_H)) + (size_t)mn * D) + F.lane;
#pragma unroll
          for (int j = 0; j < 8; ++j) nx[j] = xn[64 * j]; }
        f32x4 v[8]; float s = 0.f;
#pragma unroll
        for (int j = 0; j < 8; ++j) { const u32x2 hw = cur[j]; v[j] = (f32x4){bflo(hw.x), bfhi(hw.x), bflo(hw.y), bfhi(hw.y)}; s += (v[j].x * v[j].x + v[j].y * v[j].y) + (v[j].z * v[j].z + v[j].w * v[j].w); }
        const float rstd = rsqrtf(wave_sum(s) * (1.f / D) + EPS);
        f32x4* o = (f32x4*)(F.out + (size_t)m * D) + F.lane;
#pragma unroll
        for (int j = 0; j < 8; ++j) __builtin_nontemporal_store(v[j] * rstd * gg[j], o + 64 * j);
#pragma unroll
        for (int j = 0; j < 8; ++j) cur[j] = nx[j];
    }
}

__device__ __forceinline__ void bg_after(const Frame& F, const pg8::StaticOrder& S, int c, int kind, int lf, int kind2 = -1, int lf2 = 0, int kind3 = -1, int lf3 = 0) {
    if (kind < 0) return;
    const int rounds = (S.nwg + F.G - 1) / F.G, c0 = S.nwg - (rounds - 1) * F.G, nid = F.G - c0;
    const int rank = nid == 0 ? c : c - c0, nidle = nid == 0 ? F.G : nid;
    if (rank < 0) return;
    bg_convert(F, kind, lf, rank, nidle);
    if (kind2 >= 0) bg_convert(F, kind2, lf2, rank, nidle);
    if (kind3 >= 0) bg_convert(F, kind3, lf3, rank, nidle);
}
__device__ __forceinline__ void ph_gemm_bf16(const Frame& F, const pg8::Gemm g, const pg8::EpiBf16 E, int M_, int N_, int rot = 0, int bgkind = -1, int bglf = 0, int bgkind2 = -1, int bglf2 = 0, int bgkind3 = -1, int bglf3 = 0) {
    const int c = (int)((blockIdx.x + rot) % F.G);
    pg8::StaticOrder S; S.init(M_, N_, F.G, c); S.ntk = g.K / pg8::BK; if (N_ == DINP) S.wgm = 4; pg8::gemm_phase(F.lds, F.tid, g, S, E);
    bg_after(F, S, c, bgkind, bglf, bgkind2, bglf2, bgkind3, bglf3);
}
__device__ __forceinline__ void ph_gemm_resid(const Frame& F, const pg8::Gemm g, const pg8::EpiResid E, int ctx) {
    pg8::TailSplitOrder S; S.init(g.K, F.G, (int)blockIdx.x, ctx, 4); pg8::gemm_phase(F.lds, F.tid, g, S, E);
}
__device__ __forceinline__ void ph_gemm_swiglu(const Frame& F, const pg8::Gemm g, const pg8::EpiSwiGLU E, int M_, int N_, int bgkind = -1, int bglf = 0, int bgkind2 = -1, int bglf2 = 0) {
    const int c = (int)blockIdx.x;
    pg8::StaticOrder S; S.init(M_, N_, F.G, c); S.ntk = g.K / pg8::BK; pg8::gemm_phase(F.lds, F.tid, g, S, E);
    bg_after(F, S, c, bgkind, bglf, bgkind2, bglf2);
}

namespace fa {
typedef float f32x16 __attribute__((ext_vector_type(16)));
__device__ __forceinline__ float xhalf_max(float x) { const auto r = __builtin_amdgcn_permlane32_swap(__builtin_bit_cast(unsigned, x), __builtin_bit_cast(unsigned, x), false, false);
    return fmaxf(__builtin_bit_cast(float, (unsigned)r[0]), __builtin_bit_cast(float, (unsigned)r[1])); }
__device__ __forceinline__ float xhalf_sum(float x) { const auto r = __builtin_amdgcn_permlane32_swap(__builtin_bit_cast(unsigned, x), __builtin_bit_cast(unsigned, x), false, false);
    return __builtin_bit_cast(float, (unsigned)r[0]) + __builtin_bit_cast(float, (unsigned)r[1]); }
struct KeySrc {
    const bf16* Kb; int kpitch;
    const bf16* Vt; int vpitch;
    int row0, n0, row1, n1;
    int kpos1; int mask;
};
template <int DQK> struct Geo { static constexpr int KROW = DQK * 2 + 16, KBUF = 64 * KROW, VROW = 136, VBUF = 64 * VROW, BUF = KBUF + VBUF, KCH = DQK / 8, NKC = 64 * KCH; };

template <int DQK, int ROPE>
__device__ __forceinline__ void attn_unit(LAS unsigned char* lds, const int tid, const KeySrc& U, const bf16* qrow, const int tpos, const int qpos,
                                          const bool has_sink, const float sink_l2, const float scale_l2, bf16* orow) {
    typedef Geo<DQK> G;
    const int lane = tid & 63, h = lane >> 5, r = lane & 31;
    constexpr int NS = DQK / 16;
    bf16x8 qf[NS];
#pragma unroll
    for (int s = 0; s < NS; ++s) qf[s] = *(const bf16x8*)(qrow + 16 * s + 8 * h);
    if (ROPE == 1) {
#pragma unroll
        for (int s = 4; s < 6; ++s) {
            const u32x4 lo = *(const u32x4*)(qrow + 16 * s), hi = *(const u32x4*)(qrow + 16 * s + 8);
            const int pos = (s == 4) ? (tpos >> 6) : (tpos & 63);
            const f32x4 c0 = *(const f32x4*)(ROPE_COS_8 + pos * 8), c1 = *(const f32x4*)(ROPE_COS_8 + pos * 8 + 4), s0 = *(const f32x4*)(ROPE_SIN_8 + pos * 8), s1 = *(const f32x4*)(ROPE_SIN_8 + pos * 8 + 4);
            const float a[8] = {bflo(lo.x), bfhi(lo.x), bflo(lo.y), bfhi(lo.y), bflo(lo.z), bfhi(lo.z), bflo(lo.w), bfhi(lo.w)};
            const float b[8] = {bflo(hi.x), bfhi(hi.x), bflo(hi.y), bfhi(hi.y), bflo(hi.z), bfhi(hi.z), bflo(hi.w), bfhi(hi.w)};
            const float cs[8] = {c0.x, c0.y, c0.z, c0.w, c1.x, c1.y, c1.z, c1.w}, sn[8] = {s0.x, s0.y, s0.z, s0.w, s1.x, s1.y, s1.z, s1.w};
            float o[8];
#pragma unroll
            for (int i = 0; i < 8; ++i) o[i] = h ? (b[i] * cs[i] + a[i] * sn[i]) : (a[i] * cs[i] - b[i] * sn[i]);
            u32x4 w; w.x = pk2(o[0], o[1]); w.y = pk2(o[2], o[3]); w.z = pk2(o[4], o[5]); w.w = pk2(o[6], o[7]);
            qf[s] = __builtin_bit_cast(bf16x8, w);
        }
    }
    if (ROPE == 2) {
#pragma unroll
        for (int sp = 0; sp < 2; ++sp) {
            const int pos = sp ? (tpos & 63) : (tpos >> 6);
            const u32x4 lo = __builtin_bit_cast(u32x4, qf[2 * sp]), hi = __builtin_bit_cast(u32x4, qf[2 * sp + 1]);
            const f32x4 c0 = *(const f32x4*)(ROPE_COS_16 + pos * 16 + 8 * h), c1 = *(const f32x4*)(ROPE_COS_16 + pos * 16 + 8 * h + 4), s0 = *(const f32x4*)(ROPE_SIN_16 + pos * 16 + 8 * h), s1 = *(const f32x4*)(ROPE_SIN_16 + pos * 16 + 8 * h + 4);
            const float a[8] = {bflo(lo.x), bfhi(lo.x), bflo(lo.y), bfhi(lo.y), bflo(lo.z), bfhi(lo.z), bflo(lo.w), bfhi(lo.w)};
            const float b[8] = {bflo(hi.x), bfhi(hi.x), bflo(hi.y), bfhi(hi.y), bflo(hi.z), bfhi(hi.z), bflo(hi.w), bfhi(hi.w)};
            const float cs[8] = {c0.x, c0.y, c0.z, c0.w, c1.x, c1.y, c1.z, c1.w}, sn[8] = {s0.x, s0.y, s0.z, s0.w, s1.x, s1.y, s1.z, s1.w};
            float oa[8], ob[8];
#pragma unroll
            for (int i = 0; i < 8; ++i) { oa[i] = a[i] * cs[i] - b[i] * sn[i]; ob[i] = b[i] * cs[i] + a[i] * sn[i]; }
            u32x4 w; w.x = pk2(oa[0], oa[1]); w.y = pk2(oa[2], oa[3]); w.z = pk2(oa[4], oa[5]); w.w = pk2(oa[6], oa[7]); qf[2 * sp] = __builtin_bit_cast(bf16x8, w);
            w.x = pk2(ob[0], ob[1]); w.y = pk2(ob[2], ob[3]); w.z = pk2(ob[4], ob[5]); w.w = pk2(ob[6], ob[7]); qf[2 * sp + 1] = __builtin_bit_cast(bf16x8, w);
        }
    }
    f32x16 o0, o1;
#pragma unroll
    for (int i = 0; i < 16; ++i) { o0[i] = 0.f; o1[i] = 0.f; }
    float mrun = -INFINITY, lrun = 0.f;
    const int ntiles = U.n0 + U.n1;
    u32x4 kA0, kA1, vA, kB0, kB1, vB;
    const int kc0 = tid, kc1 = tid + 512;
    const int krow0 = kc0 / G::KCH, kpart0 = kc0 % G::KCH, krow1 = kc1 / G::KCH, kpart1 = kc1 % G::KCH;
    const int vd = tid >> 3, vpart = tid & 7;
#define FA_LOAD(j, K0, K1, V) do { const int _j = (j); const int R0 = _j < U.n0 ? U.row0 + 64 * _j : U.row1 + 64 * (_j - U.n0); \
        K0 = *(const u32x4*)(U.Kb + (size_t)(R0 + krow0) * U.kpitch + kpart0 * 8); \
        if (G::NKC > 512 && kc1 < G::NKC) K1 = *(const u32x4*)(U.Kb + (size_t)(R0 + krow1) * U.kpitch + kpart1 * 8); \
        V = *(const u32x4*)(U.Vt + (size_t)vd * U.vpitch + R0 + vpart * 8); } while (0)
#define FA_STORE(b, K0, K1, V) do { LAS unsigned char* _base = lds + (b) * G::BUF; \
        *(LAS u32x4*)(_base + krow0 * G::KROW + kpart0 * 16) = K0; \
        if (G::NKC > 512 && kc1 < G::NKC) *(LAS u32x4*)(_base + krow1 * G::KROW + kpart1 * 16) = K1; \
        *(LAS u32x2*)(_base + G::KBUF + vd * G::VROW + vpart * 16) = (u32x2){V.x, V.y}; *(LAS u32x2*)(_base + G::KBUF + vd * G::VROW + vpart * 16 + 8) = (u32x2){V.z, V.w}; } while (0)
#define FA_TILE(j) do { \
        const LAS unsigned char* cur = lds + ((j) & 1) * G::BUF; \
          \
        bf16x8 kf0[NS], kf1[NS]; \
        _Pragma("unroll") for (int s = 0; s < NS; ++s) { \
            kf0[s] = *(const LAS bf16x8*)(cur + r * G::KROW + (16 * s + 8 * h) * 2); \
            kf1[s] = *(const LAS bf16x8*)(cur + (32 + r) * G::KROW + (16 * s + 8 * h) * 2); } \
        asm volatile("s_waitcnt lgkmcnt(0)" ::: "memory"); __builtin_amdgcn_sched_barrier(0); \
        f32x16 s0 = __builtin_amdgcn_mfma_f32_32x32x16_bf16(kf0[0], qf[0], zero16, 0, 0, 0), s1 = __builtin_amdgcn_mfma_f32_32x32x16_bf16(kf1[0], qf[0], zero16, 0, 0, 0); \
        _Pragma("unroll") for (int s = 1; s < NS; ++s) { \
            s0 = __builtin_amdgcn_mfma_f32_32x32x16_bf16(kf0[s], qf[s], s0, 0, 0, 0); \
            s1 = __builtin_amdgcn_mfma_f32_32x32x16_bf16(kf1[s], qf[s], s1, 0, 0, 0); } \
          \
        const LAS unsigned char* vb = cur + G::KBUF; \
        u32x2 vl0[4], vh0[4], vl1[4], vh1[4]; \
        _Pragma("unroll") for (int ks = 0; ks < 4; ++ks) { \
            vl0[ks] = *(const LAS u32x2*)(vb + r * G::VROW + (16 * ks + 4 * h) * 2); vh0[ks] = *(const LAS u32x2*)(vb + r * G::VROW + (16 * ks + 8 + 4 * h) * 2); \
            vl1[ks] = *(const LAS u32x2*)(vb + (32 + r) * G::VROW + (16 * ks + 4 * h) * 2); vh1[ks] = *(const LAS u32x2*)(vb + (32 + r) * G::VROW + (16 * ks + 8 + 4 * h) * 2); } \
        __builtin_amdgcn_sched_barrier(0); \
        if (U.mask && (j) >= U.n0) { \
            const int kp0 = U.kpos1 + 64 * ((j) - U.n0) + 4 * h - qpos; \
            _Pragma("unroll") for (int i = 0; i < 16; ++i) { const int rel = kp0 + (i & 3) + 8 * (i >> 2); \
                if (rel > 128 || rel < -128) s0[i] = -INFINITY; \
                if (rel + 32 > 128 || rel + 32 < -128) s1[i] = -INFINITY; } } \
        float tmax = fmaxf(s0[0], s1[0]); \
        _Pragma("unroll") for (int i = 1; i < 16; ++i) tmax = fmaxf(tmax, fmaxf(s0[i], s1[i])); \
        tmax = xhalf_max(tmax) * scale_l2; \
        if (__any(tmax > mrun + 8.f)) {            \
            const float mnew = fmaxf(mrun, tmax); const float alpha = __builtin_amdgcn_exp2f(mrun - mnew); \
            lrun *= alpha; mrun = mnew; \
            _Pragma("unroll") for (int i = 0; i < 16; ++i) { o0[i] *= alpha; o1[i] *= alpha; } } \
        float rs = 0.f; \
        _Pragma("unroll") for (int i = 0; i < 16; ++i) { s0[i] = __builtin_amdgcn_exp2f(s0[i] * scale_l2 - mrun); s1[i] = __builtin_amdgcn_exp2f(s1[i] * scale_l2 - mrun); rs += s0[i] + s1[i]; } \
        lrun += rs; \
        bf16x8 pf[4]; \
        { u32x4 w; \
          w.x = pg8::cvt_pk_bf16(s0[0], s0[1]); w.y = pg8::cvt_pk_bf16(s0[2], s0[3]); w.z = pg8::cvt_pk_bf16(s0[4], s0[5]); w.w = pg8::cvt_pk_bf16(s0[6], s0[7]); pf[0] = __builtin_bit_cast(bf16x8, w); \
          w.x = pg8::cvt_pk_bf16(s0[8], s0[9]); w.y = pg8::cvt_pk_bf16(s0[10], s0[11]); w.z = pg8::cvt_pk_bf16(s0[12], s0[13]); w.w = pg8::cvt_pk_bf16(s0[14], s0[15]); pf[1] = __builtin_bit_cast(bf16x8, w); \
          w.x = pg8::cvt_pk_bf16(s1[0], s1[1]); w.y = pg8::cvt_pk_bf16(s1[2], s1[3]); w.z = pg8::cvt_pk_bf16(s1[4], s1[5]); w.w = pg8::cvt_pk_bf16(s1[6], s1[7]); pf[2] = __builtin_bit_cast(bf16x8, w); \
          w.x = pg8::cvt_pk_bf16(s1[8], s1[9]); w.y = pg8::cvt_pk_bf16(s1[10], s1[11]); w.z = pg8::cvt_pk_bf16(s1[12], s1[13]); w.w = pg8::cvt_pk_bf16(s1[14], s1[15]); pf[3] = __builtin_bit_cast(bf16x8, w); } \
        asm volatile("s_waitcnt lgkmcnt(0)" ::: "memory"); __builtin_amdgcn_sched_barrier(0); \
        _Pragma("unroll") for (int ks = 0; ks < 4; ++ks) { \
            const u32x4 f0 = {vl0[ks].x, vl0[ks].y, vh0[ks].x, vh0[ks].y}, f1 = {vl1[ks].x, vl1[ks].y, vh1[ks].x, vh1[ks].y}; \
            o0 = __builtin_amdgcn_mfma_f32_32x32x16_bf16(__builtin_bit_cast(bf16x8, f0), pf[ks], o0, 0, 0, 0); \
            o1 = __builtin_amdgcn_mfma_f32_32x32x16_bf16(__builtin_bit_cast(bf16x8, f1), pf[ks], o1, 0, 0, 0); } \
    } while (0)
    f32x16 zero16;
#pragma unroll
    for (int i = 0; i < 16; ++i) zero16[i] = 0.f;
    FA_LOAD(0, kA0, kA1, vA); if (ntiles > 1) FA_LOAD(1, kB0, kB1, vB);
    FA_STORE(0, kA0, kA1, vA); __syncthreads();
    for (int j = 0; j < ntiles; j += 2) {
        if (j + 2 < ntiles) FA_LOAD(j + 2, kA0, kA1, vA);
        FA_TILE(j);
        if (j + 1 < ntiles) FA_STORE(1, kB0, kB1, vB);
        __syncthreads();
        if (j + 1 < ntiles) {
            if (j + 3 < ntiles) FA_LOAD(j + 3, kB0, kB1, vB);
            FA_TILE(j + 1);
            if (j + 2 < ntiles) FA_STORE(0, kA0, kA1, vA);
            __syncthreads();
        }
    }
#undef FA_LOAD
#undef FA_STORE
#undef FA_TILE
    lrun = xhalf_sum(lrun);
    if (has_sink) lrun += __builtin_amdgcn_exp2f(sink_l2 - mrun);
    const float inv = 1.f / lrun;
#pragma unroll
    for (int g4 = 0; g4 < 4; ++g4) {
        u32x2 w0, w1;
        w0.x = pk2(o0[4 * g4] * inv, o0[4 * g4 + 1] * inv); w0.y = pk2(o0[4 * g4 + 2] * inv, o0[4 * g4 + 3] * inv);
        w1.x = pk2(o1[4 * g4] * inv, o1[4 * g4 + 1] * inv); w1.y = pk2(o1[4 * g4 + 2] * inv, o1[4 * g4 + 3] * inv);
        *(u32x2*)(orow + 8 * g4 + 4 * h) = w0; *(u32x2*)(orow + 32 + 8 * g4 + 4 * h) = w1;
    }
}
}

__device__ __forceinline__ void ph_attn(const Frame& F, int l) {
    const int tid = F.tid, w = F.wave, r = F.lane & 31;
    bf16* QM = ((bf16*)(F.ws + WS_QM)); bf16* KM = ((bf16*)(F.ws + WS_KM)); bf16* VT = ((bf16*)(F.ws + WS_VT));
    bf16* KS = ((bf16*)(F.ws + WS_KS)); bf16* VST = ((bf16*)(F.ws + WS_VST)); bf16* P = ((bf16*)(F.ws + WS_P));
    bf16* MX = ((bf16*)(F.ws + WS_MX)); bf16* SX = ((bf16*)(F.ws + WS_SX));
    const float sc_mla = 0.10206207261596575f * LOG2E, sc_swa = 0.125f * LOG2E;
    const int gsz = F.G >> 3, xg = F.vcu / gsz, nlist = l == DEPTH - 1 ? 128 : 136;
    unsigned* ctr = (unsigned*)(F.ws + WS_CTL) + 8192 + 512 * l + 64 * xg;
    volatile LAS unsigned* mail = (volatile LAS unsigned*)(F.lds + MISC_OFF + 64);
    unsigned ntick = 0;
    for (int li = F.vcu % gsz; li < nlist; ) {
        if (tid == 0) ntick = __hip_atomic_fetch_add(ctr, 1u, __ATOMIC_RELAXED, __HIP_MEMORY_SCOPE_AGENT) + (unsigned)gsz;
        const int u = li < 64 ? xg * 64 + li : li < 128 ? 512 + xg * 64 + (li - 64) : li < 132 ? 1024 + xg * 4 + (li - 128) : 1056 + xg * 4 + (li - 132);
        if (u < 512) {
            const int b = u >> 7, hh = (u >> 4) & 7, qb = u & 15;
            fa::KeySrc U{KM + hh * 96, 768, VT + (size_t)(hh * 64) * MT, MT, b * SEQ, 64, ML + b * CTX, 4, 0, 0};
            const int t = qb * 256 + 32 * w + r, row = b * SEQ + t;
            fa::attn_unit<96, 1>(F.lds, tid, U, QM + (size_t)row * 768 + hh * 96, t, 0, false, 0.f, sc_mla, MX + (size_t)row * 512 + hh * 64);
        } else if (u < 1024) {
            const int v = u - 512, b = v >> 7, g = (v >> 6) & 1, pb = v & 63;
            const int ks = pb * 64 - 128 < 0 ? 0 : pb * 64 - 128, ke = pb * 64 + 192 > SEQ ? SEQ : pb * 64 + 192;
            fa::KeySrc U{KS + g * 64, 128, VST + (size_t)(g * 64) * MT, MT, ML + b * CTX, 4, b * SEQ + ks, (ke - ks) >> 6, ks, 1};
            const int hq = 4 * g + (w >> 1), t = pb * 64 + 32 * (w & 1) + r, row = b * SEQ + t;
            fa::attn_unit<64, 2>(F.lds, tid, U, P + (size_t)row * DINP + PC_QS + hq * 64, t, t, true, INP(I_SINK)[l * 8 + hq] * LOG2E, sc_swa, SX + (size_t)row * 512 + hq * 64);
        } else if (u < 1056) {
            const int v = u - 1024, b = v >> 3, hh = v & 7;
            fa::KeySrc U{KM + hh * 96, 768, VT + (size_t)(hh * 64) * MT, MT, ML + b * CTX, 4, 0, 0, 0, 0};
            const int row = ML + b * CTX + 32 * w + r;
            fa::attn_unit<96, 0>(F.lds, tid, U, QM + (size_t)row * 768 + hh * 96, 0, 0, false, 0.f, sc_mla, MX + (size_t)row * 512 + hh * 64);
        } else {
            const int v = u - 1056, b = v >> 3, g = (v >> 2) & 1, hq = 4 * g + (v & 3);
            fa::KeySrc U{KS + g * 64, 128, VST + (size_t)(g * 64) * MT, MT, ML + b * CTX, 4, 0, 0, 0, 0};
            const int row = ML + b * CTX + 32 * w + r;
            fa::attn_unit<64, 0>(F.lds, tid, U, P + (size_t)row * DINP + PC_QS + hq * 64, 0, 0, true, INP(I_SINK)[l * 8 + hq] * LOG2E, sc_swa, SX + (size_t)row * 512 + hq * 64);
        }
        if (tid == 0) mail[0] = ntick;
        __syncthreads();
        li = (int)mail[0];
    }
}

__device__ __forceinline__ int chunk_row0(int c) { const int b = c / 34, cix = c % 34; return cix < 2 ? ML + b * CTX + 128 * cix : b * SEQ + 128 * (cix - 2); }
__device__ __forceinline__ bf16x8 ld_frag(const bf16* p) { return *(const bf16x8*)p; }
__device__ __forceinline__ f32x4 mfma16(bf16x8 a, bf16x8 b, f32x4 c) { return __builtin_amdgcn_mfma_f32_16x16x32_bf16(a, b, c, 0, 0, 0); }

__device__ __forceinline__ void ph_conv(const Frame& F, int l) {
    const int tid = F.tid;
    bf16* P = ((bf16*)(F.ws + WS_P)); bf16* XST = ((bf16*)(F.ws + WS_XS)); bf16* BT = ((bf16*)(F.ws + WS_BT)); bf16* BC = ((bf16*)(F.ws + WS_BC));
    const float* cw = INP(I_CONVW) + (size_t)l * 5 * 1536; const float* cbias = INP(I_CONVB) + (size_t)l * 1536;
    LAS unsigned char* tin = F.lds; LAS unsigned char* tout = F.lds + 36864;
    u32x4 rin[5];
#define CV_LOAD(u) do { const int c_ = (u) / 12, cb_ = (u) % 12, b_ = c_ / 34, cix_ = c_ % 34; \
        const int row0_ = chunk_row0(c_), lo_ = cix_ < 2 ? ML + b_ * CTX : b_ * SEQ, hi_ = cix_ < 2 ? lo_ + CTX : lo_ + SEQ; \
        _Pragma("unroll") for (int i = 0; i < 5; ++i) { const int idx = tid + 512 * i, ri = idx >> 4, part = idx & 15, grow = row0_ - 2 + ri; \
            rin[i] = (u32x4){0u, 0u, 0u, 0u}; \
            if (idx < 132 * 16 && grow >= lo_ && grow < hi_) rin[i] = *(const u32x4*)(P + (size_t)grow * DINP + PC_XBC + cb_ * 128 + part * 8); } } while (0)
#define CV_STORE() do { _Pragma("unroll") for (int i = 0; i < 5; ++i) { const int idx = tid + 512 * i, ri = idx >> 4, part = idx & 15; \
            if (idx < 132 * 16) *(LAS u32x4*)(tin + ri * 272 + part * 16) = rin[i]; } } while (0)
    int u = F.vcu;
    if (u < 136 * 12) { CV_LOAD(u); CV_STORE(); }
    __syncthreads();
    for (; u < 136 * 12; u += F.G) {
        const int c = u / 12, cb = u % 12, ch0 = cb * 128;
        const int row0 = chunk_row0(c);
        const int un = u + F.G;
        const float w0 = cw[ch0 + (tid & 127)], w1 = cw[1536 + ch0 + (tid & 127)], w2 = cw[2 * 1536 + ch0 + (tid & 127)], w3 = cw[3 * 1536 + ch0 + (tid & 127)], w4 = cw[4 * 1536 + ch0 + (tid & 127)], bs = cbias[ch0 + (tid & 127)];
        if (un < 136 * 12) CV_LOAD(un);
        {
            const int ch = tid & 127, q = tid >> 7, t0 = 32 * q;
            const LAS bf16* col = (const LAS bf16*)tin + ch;
            float x0 = bf2f(col[(t0 + 0) * 136]), x1 = bf2f(col[(t0 + 1) * 136]), x2 = bf2f(col[(t0 + 2) * 136]), x3 = bf2f(col[(t0 + 3) * 136]);
#pragma unroll 4
            for (int tp = 0; tp < 16; ++tp) {
                const int t = t0 + 2 * tp;
                const float x4 = bf2f(col[(t + 4) * 136]), x5 = bf2f(col[(t + 5) * 136]);
                const float y0 = pg8::silu_fast(bs + w0 * x0 + w1 * x1 + w2 * x2 + w3 * x3 + w4 * x4), y1 = pg8::silu_fast(bs + w0 * x1 + w1 * x2 + w2 * x3 + w3 * x4 + w4 * x5);
                if (cb < 10) *(LAS unsigned*)(tout + ch * 264 + t * 2) = pk2(y0, y1);
                if (cb >= 8) { BC[(size_t)(row0 + t) * 512 + (cb - 8) * 128 + ch] = (bf16)f2bf(y0); BC[(size_t)(row0 + t + 1) * 512 + (cb - 8) * 128 + ch] = (bf16)f2bf(y1); }
                x0 = x2; x1 = x3; x2 = x4; x3 = x5;
            }
        }
        __syncthreads();
        if (cb < 10) {
            bf16* dst = cb < 8 ? XST + ((size_t)c * 1024 + ch0) * 128 : BT + ((size_t)c * 256 + (cb - 8) * 128) * 128;
            for (int idx = tid; idx < 128 * 32; idx += 512) { const int chl = idx >> 5, part = idx & 31;
                *(u32x2*)(dst + (size_t)chl * 128 + part * 4) = *(const LAS u32x2*)(tout + chl * 264 + part * 8); }
        }
        if (un < 136 * 12) CV_STORE();
        __syncthreads();
    }
#undef CV_LOAD
#undef CV_STORE
}

__device__ __forceinline__ void ph_dtcum(const Frame& F, int l) {
    const int gw = F.vcu * NWAVES + F.wave, NGW = F.G * NWAVES, lane = F.lane;
    bf16* P = ((bf16*)(F.ws + WS_P)); float* CUM = ((float*)(F.ws + WS_CUM)); float* DEC = ((float*)(F.ws + WS_DEC)); float* WL = ((float*)(F.ws + WS_DT));
    for (int it = gw; it < 136 * 32; it += NGW) {
        const int d = it & 1, h = (it >> 1) & 15, c = it >> 5, row0 = chunk_row0(c);
        const float A = -__expf(INP(I_ALOG)[l * 32 + d * 16 + h]), bias = INP(I_DTB)[l * 32 + d * 16 + h];
        const float v0 = bf2f(P[(size_t)(row0 + 2 * lane) * DINP + PC_DT + d * 16 + h]) + bias, v1 = bf2f(P[(size_t)(row0 + 2 * lane + 1) * DINP + PC_DT + d * 16 + h]) + bias;
        const float dt0 = v0 > 20.f ? v0 : log1pf(__expf(v0)), dt1 = v1 > 20.f ? v1 : log1pf(__expf(v1));
        const float a0 = dt0 * A, a1 = dt1 * A;
        float incl = a0 + a1;
#pragma unroll
        for (int o = 1; o < 64; o <<= 1) { const float t = __shfl_up(incl, o); if (lane >= o) incl += t; }
        const float T = __shfl(incl, 63);
        float c0, c1;
        if (d == 0) { c1 = incl; c0 = incl - a1; } else { c0 = T - incl + a0 + a1; c1 = T - incl + a1; }
        const size_t u = (size_t)c * 16 + h;
        *(f32x2*)(WL + u * 256 + d * 128 + 2 * lane) = (f32x2){dt0 * __expf(T - c0), dt1 * __expf(T - c1)};
        *(f32x2*)(CUM + u * 512 + d * 128 + 2 * lane) = (f32x2){c0, c1}; *(f32x2*)(CUM + u * 512 + 256 + d * 128 + 2 * lane) = (f32x2){dt0, dt1};
        if (lane == 0) DEC[(c * 2 + d) * 16 + h] = __expf(T);
    }
}
__device__ __forceinline__ void ph_ssd_a(const Frame& F, int l) {
    const int tid = F.tid, lane = F.lane, w = F.wave, fr = lane & 15, fq = lane >> 4;
    bf16* XST = ((bf16*)(F.ws + WS_XS)); bf16* BT = ((bf16*)(F.ws + WS_BT)); bf16* BC = ((bf16*)(F.ws + WS_BC)); bf16* CBb = ((bf16*)(F.ws + WS_CB)); bf16* ST = ((bf16*)(F.ws + WS_ST));
    const float* WL = ((float*)(F.ws + WS_DT));
    constexpr int SETB = 53248;
    const int NU = 136 * 16;
    u32x4 rx[2], rb[4];
#define SA_LOAD(u) do { const int c_ = (u) >> 4, h_ = (u) & 15, g_ = h_ >> 3; \
        _Pragma("unroll") for (int i = 0; i < 2; ++i) { const int idx = tid + 512 * i; rx[i] = *(const u32x4*)(XST + ((size_t)(c_ * 16 + h_) * 64 + (idx >> 4)) * 128 + (idx & 15) * 8); } \
        _Pragma("unroll") for (int i = 0; i < 4; ++i) { const int idx = tid + 512 * i; rb[i] = *(const u32x4*)(BT + ((size_t)(c_ * 2 + g_) * 128 + (idx >> 4)) * 128 + (idx & 15) * 8); } } while (0)
#define SA_STORE(base) do { \
        _Pragma("unroll") for (int i = 0; i < 2; ++i) { const int idx = tid + 512 * i; *(LAS u32x4*)((base) + (idx >> 4) * 272 + (idx & 15) * 16) = rx[i]; } \
        _Pragma("unroll") for (int i = 0; i < 4; ++i) { const int idx = tid + 512 * i; *(LAS u32x4*)((base) + 17408 + (idx >> 4) * 272 + (idx & 15) * 16) = rb[i]; } } while (0)
    int u = F.vcu, cur = 0;
    if (u < NU) { SA_LOAD(u); SA_STORE(F.lds); }
    __syncthreads();
    for (; u < NU; u += F.G, cur ^= 1) {
        const int un = u + F.G;
        const float* wl = WL + (size_t)u * 256 + 8 * fq;
        f32x4 wa[4][2], wb[4][2];
#pragma unroll
        for (int kk = 0; kk < 4; ++kk) { wa[kk][0] = *(const f32x4*)(wl + 32 * kk); wa[kk][1] = *(const f32x4*)(wl + 32 * kk + 4); wb[kk][0] = *(const f32x4*)(wl + 128 + 32 * kk); wb[kk][1] = *(const f32x4*)(wl + 128 + 32 * kk + 4); }
        if (un < NU) SA_LOAD(un);
        const LAS unsigned char* lx = F.lds + cur * SETB; const LAS unsigned char* lb = lx + 17408;
        const int c = u >> 4, h = u & 15;
        bf16x8 afa[4], afb[4];
#pragma unroll
        for (int kk = 0; kk < 4; ++kk) {
            const u32x4 bw = *(const LAS u32x4*)(lb + (16 * w + fr) * 272 + 16 * fq + 64 * kk);
            const float x[8] = {bflo(bw.x), bfhi(bw.x), bflo(bw.y), bfhi(bw.y), bflo(bw.z), bfhi(bw.z), bflo(bw.w), bfhi(bw.w)};
            const f32x4 wa0 = wa[kk][0], wa1 = wa[kk][1], wb0 = wb[kk][0], wb1 = wb[kk][1];
            u32x4 xa, xb;
            xa.x = pk2(x[0] * wa0.x, x[1] * wa0.y); xa.y = pk2(x[2] * wa0.z, x[3] * wa0.w); xa.z = pk2(x[4] * wa1.x, x[5] * wa1.y); xa.w = pk2(x[6] * wa1.z, x[7] * wa1.w);
            xb.x = pk2(x[0] * wb0.x, x[1] * wb0.y); xb.y = pk2(x[2] * wb0.z, x[3] * wb0.w); xb.z = pk2(x[4] * wb1.x, x[5] * wb1.y); xb.w = pk2(x[6] * wb1.z, x[7] * wb1.w);
            afa[kk] = __builtin_bit_cast(bf16x8, xa); afb[kk] = __builtin_bit_cast(bf16x8, xb);
        }
#pragma unroll
        for (int jp = 0; jp < 4; ++jp) {
            f32x4 acc0 = {0.f, 0.f, 0.f, 0.f}, acc1 = acc0;
            bf16x8 xf[4];
#pragma unroll
            for (int kk = 0; kk < 4; ++kk) xf[kk] = *(const LAS bf16x8*)(lx + (16 * jp + fr) * 272 + 16 * fq + 64 * kk);
#pragma unroll
            for (int kk = 0; kk < 4; ++kk) {
                acc0 = mfma16(afa[kk], xf[kk], acc0);
                acc1 = mfma16(afb[kk], xf[kk], acc1);
            }
            const int p = 16 * jp + fr, n = 16 * w + 4 * fq;
            u32x2 o0, o1; o0.x = pk2(acc0[0], acc0[1]); o0.y = pk2(acc0[2], acc0[3]); o1.x = pk2(acc1[0], acc1[1]); o1.y = pk2(acc1[2], acc1[3]);
            *(u32x2*)(ST + ((size_t)((c * 2 + 0) * 16 + h) * 64 + p) * 128 + n) = o0;
            *(u32x2*)(ST + ((size_t)((c * 2 + 1) * 16 + h) * 64 + p) * 128 + n) = o1;
        }
        if (un < NU) SA_STORE(F.lds + (cur ^ 1) * SETB);
        __syncthreads();
    }
#undef SA_LOAD
#undef SA_STORE
    for (int v = F.vcu; v < 136 * 2; v += F.G) {
        const int c = v >> 1, g = v & 1, row0 = chunk_row0(c);
        bf16x8 af[4];
        const bf16* bp = BC + (size_t)(row0 + 16 * w + fr) * 512 + g * 128 + 8 * fq;
#pragma unroll
        for (int kk = 0; kk < 4; ++kk) af[kk] = ld_frag(bp + 32 * kk);
#pragma unroll
        for (int jh = 0; jh < 8; jh += 4) {
            bf16x8 cf[4][4];
#pragma unroll
            for (int jx = 0; jx < 4; ++jx) { const bf16* cp = BC + (size_t)(row0 + 16 * (jh + jx) + fr) * 512 + 256 + g * 128 + 8 * fq;
#pragma unroll
                for (int kk = 0; kk < 4; ++kk) cf[jx][kk] = ld_frag(cp + 32 * kk); }
#pragma unroll
            for (int jx = 0; jx < 4; ++jx) { const int jl = jh + jx;
                f32x4 acc = {0.f, 0.f, 0.f, 0.f};
#pragma unroll
                for (int kk = 0; kk < 4; ++kk) acc = mfma16(af[kk], cf[jx][kk], acc);
                const int li = 16 * jl + fr, s = 16 * w + 4 * fq;
                u32x2 o; o.x = pk2(acc[0], acc[1]); o.y = pk2(acc[2], acc[3]);
                *(u32x2*)(CBb + ((size_t)(c * 2 + g) * 128 + li) * 128 + s) = o; }
        }
    }
}

__device__ __forceinline__ void ph_ssd_scan(const Frame& F) {
    const size_t gtid = (size_t)F.vcu * 512 + F.tid, gth = (size_t)F.G * 512;
    bf16* ST = ((bf16*)(F.ws + WS_ST)); const float* DEC = ((float*)(F.ws + WS_DEC));
    for (size_t idx = gtid; idx < 131072; idx += gth) {
        const int nch = idx & 15, p = (idx >> 4) & 63, h = (idx >> 10) & 15, d = (idx >> 14) & 1, b = (int)(idx >> 15);
        float hr[8]; float zz = 0.f; asm volatile("" : "+v"(zz));
#pragma unroll
        for (int j = 0; j < 8; ++j) hr[j] = zz;
#define SCN_C(step) (b * 34 + (d == 0 ? (step) : ((step) < 2 ? 1 - (step) : 35 - (step))))
#define SCN_PTR(c) ((u32x4*)(ST + ((size_t)(((c) * 2 + d) * 16 + h) * 64 + p) * 128 + nch * 8))
#pragma unroll 1
        for (int half = 0; half < 2; ++half) {
            u32x4 sv[17]; float dc[17];
#pragma unroll
            for (int s = 0; s < 17; ++s) { const int c = SCN_C(half * 17 + s); dc[s] = DEC[(c * 2 + d) * 16 + h]; }
#pragma unroll
            for (int s = 0; s < 17; ++s) { const int c = SCN_C(half * 17 + s); sv[s] = *SCN_PTR(c); }
#pragma unroll
            for (int s = 0; s < 17; ++s) {
                const int c = SCN_C(half * 17 + s); const float dec = dc[s];
                u32x4 o; o.x = pk2(hr[0], hr[1]); o.y = pk2(hr[2], hr[3]); o.z = pk2(hr[4], hr[5]); o.w = pk2(hr[6], hr[7]);
                *SCN_PTR(c) = o;
                hr[0] = dec * hr[0] + bflo(sv[s].x); hr[1] = dec * hr[1] + bfhi(sv[s].x); hr[2] = dec * hr[2] + bflo(sv[s].y); hr[3] = dec * hr[3] + bfhi(sv[s].y);
                hr[4] = dec * hr[4] + bflo(sv[s].z); hr[5] = dec * hr[5] + bfhi(sv[s].z); hr[6] = dec * hr[6] + bflo(sv[s].w); hr[7] = dec * hr[7] + bfhi(sv[s].w);
            }
        }
#undef SCN_C
#undef SCN_PTR
    }
}

__device__ __forceinline__ void ph_ssd_c(const Frame& F, int l) {
    const int tid = F.tid, lane = F.lane, w = F.wave, fr = lane & 15, fq = lane >> 4;
    bf16* XST = ((bf16*)(F.ws + WS_XS)); bf16* BC = ((bf16*)(F.ws + WS_BC)); bf16* CBb = ((bf16*)(F.ws + WS_CB)); bf16* ST = ((bf16*)(F.ws + WS_ST)); bf16* P = ((bf16*)(F.ws + WS_P));
    const float* CUM = ((float*)(F.ws + WS_CUM)); bf16* YG = ((bf16*)(F.ws + WS_YG)); float* SSQ = ((float*)(F.ws + WS_SSQ));
    constexpr int SETB = 55296;
    const int NU = 136 * 16;
    const bool lastl = (l == DEPTH - 1);
#define SC_VALID(u) (!(lastl && (((u) >> 4) % 34) < 2))
#define SC_LOAD(u) do { const int c_ = (u) >> 4, h_ = (u) & 15; \
        _Pragma("unroll") for (int i = 0; i < 2; ++i) { const int idx = tid + 512 * i, rr = idx >> 4, part = idx & 15; \
            rx[i] = *(const u32x4*)(XST + ((size_t)(c_ * 16 + h_) * 64 + rr) * 128 + part * 8); \
            rf[i] = *(const u32x4*)(ST + ((size_t)((c_ * 2 + 0) * 16 + h_) * 64 + rr) * 128 + part * 8); \
            rb[i] = *(const u32x4*)(ST + ((size_t)((c_ * 2 + 1) * 16 + h_) * 64 + rr) * 128 + part * 8); } \
        if (tid < 128) rc = *(const f32x4*)(CUM + (size_t)(u) * 512 + 4 * tid); \
        { const int g_ = h_ >> 3, r0_ = chunk_row0(c_), li_ = 16 * w + fr; \
          _Pragma("unroll") for (int kk = 0; kk < 4; ++kk) { ncb[kk] = *(const u32x4*)(CBb + ((size_t)(c_ * 2 + g_) * 128 + li_) * 128 + 32 * kk + 8 * fq); \
              ncv[kk] = *(const u32x4*)(BC + (size_t)(r0_ + li_) * 512 + 256 + g_ * 128 + 32 * kk + 8 * fq); } \
          _Pragma("unroll") for (int jp = 0; jp < 4; ++jp) nz[jp] = *(const u32x2*)(P + (size_t)(r0_ + li_) * DINP + PC_Z + h_ * 64 + 16 * jp + 4 * fq); } } while (0)
#define SC_STORE(base) do { \
        _Pragma("unroll") for (int i = 0; i < 2; ++i) { const int idx = tid + 512 * i, rr = idx >> 4, part = idx & 15; \
            *(LAS u32x4*)((base) + rr * 272 + part * 16) = rx[i]; *(LAS u32x4*)((base) + 17408 + rr * 272 + part * 16) = rf[i]; *(LAS u32x4*)((base) + 34816 + rr * 272 + part * 16) = rb[i]; } \
        if (tid < 128) *(LAS f32x4*)((base) + 52224 + 16 * tid) = rc; } while (0)
    u32x4 rx[2], rf[2], rb[2]; f32x4 rc; u32x4 ncb[4], ncv[4], ccb[4], ccv[4]; u32x2 nz[4], cz[4];
    int u = F.vcu; while (u < NU && !SC_VALID(u)) u += F.G;
    int cur = 0;
    if (u < NU) { SC_LOAD(u); SC_STORE(F.lds); }
    __syncthreads();
    while (u < NU) {
        int un = u + F.G; while (un < NU && !SC_VALID(un)) un += F.G;
#pragma unroll
        for (int kk = 0; kk < 4; ++kk) { ccb[kk] = ncb[kk]; ccv[kk] = ncv[kk]; cz[kk] = nz[kk]; }
        if (un < NU) SC_LOAD(un);
        LAS unsigned char* lx = F.lds + cur * SETB; LAS unsigned char* lhf = lx + 17408; LAS unsigned char* lhb = lx + 34816; LAS float* lc = (LAS float*)(lx + 52224);
        const int c = u >> 4, h = u & 15, g = h >> 3, row0 = chunk_row0(c);
        const float dskip = INP(I_DSKIP)[l * 16 + h];
        int li = 16 * w + fr;
        asm volatile("" : "+v"(li));
        const float cfl = lc[li], cbl = lc[128 + li];
        const float ef = __expf(cfl), eb = __expf(cbl);
        bf16x8 mf[4];
#pragma unroll
        for (int kk = 0; kk < 4; ++kk) {
            const int s0 = 32 * kk + 8 * fq;
            const u32x4 cw4 = ccb[kk];
            const float cbv[8] = {bflo(cw4.x), bfhi(cw4.x), bflo(cw4.y), bfhi(cw4.y), bflo(cw4.z), bfhi(cw4.z), bflo(cw4.w), bfhi(cw4.w)};
            float m[8];
            const int dk = w >> 1;
            if (kk < dk) {
                const f32x4 cfs0 = *(const LAS f32x4*)(lc + s0), cfs1 = *(const LAS f32x4*)(lc + s0 + 4), dtf0 = *(const LAS f32x4*)(lc + 256 + s0), dtf1 = *(const LAS f32x4*)(lc + 256 + s0 + 4);
                const float cfs[8] = {cfs0.x, cfs0.y, cfs0.z, cfs0.w, cfs1.x, cfs1.y, cfs1.z, cfs1.w}, dtf[8] = {dtf0.x, dtf0.y, dtf0.z, dtf0.w, dtf1.x, dtf1.y, dtf1.z, dtf1.w};
#pragma unroll
                for (int j = 0; j < 8; ++j) m[j] = cbv[j] * (__expf(cfl - cfs[j]) * dtf[j]);
            } else if (kk > dk) {
                const f32x4 cbs0 = *(const LAS f32x4*)(lc + 128 + s0), cbs1 = *(const LAS f32x4*)(lc + 128 + s0 + 4), dtb0 = *(const LAS f32x4*)(lc + 384 + s0), dtb1 = *(const LAS f32x4*)(lc + 384 + s0 + 4);
                const float cbs[8] = {cbs0.x, cbs0.y, cbs0.z, cbs0.w, cbs1.x, cbs1.y, cbs1.z, cbs1.w}, dtb[8] = {dtb0.x, dtb0.y, dtb0.z, dtb0.w, dtb1.x, dtb1.y, dtb1.z, dtb1.w};
#pragma unroll
                for (int j = 0; j < 8; ++j) m[j] = cbv[j] * (__expf(cbl - cbs[j]) * dtb[j]);
            } else {
                const f32x4 cfs0 = *(const LAS f32x4*)(lc + s0), cfs1 = *(const LAS f32x4*)(lc + s0 + 4);
                const f32x4 cbs0 = *(const LAS f32x4*)(lc + 128 + s0), cbs1 = *(const LAS f32x4*)(lc + 128 + s0 + 4);
                const f32x4 dtf0 = *(const LAS f32x4*)(lc + 256 + s0), dtf1 = *(const LAS f32x4*)(lc + 256 + s0 + 4);
                const f32x4 dtb0 = *(const LAS f32x4*)(lc + 384 + s0), dtb1 = *(const LAS f32x4*)(lc + 384 + s0 + 4);
                const float cfs[8] = {cfs0.x, cfs0.y, cfs0.z, cfs0.w, cfs1.x, cfs1.y, cfs1.z, cfs1.w}, cbs[8] = {cbs0.x, cbs0.y, cbs0.z, cbs0.w, cbs1.x, cbs1.y, cbs1.z, cbs1.w};
                const float dtf[8] = {dtf0.x, dtf0.y, dtf0.z, dtf0.w, dtf1.x, dtf1.y, dtf1.z, dtf1.w}, dtb[8] = {dtb0.x, dtb0.y, dtb0.z, dtb0.w, dtb1.x, dtb1.y, dtb1.z, dtb1.w};
#pragma unroll
                for (int j = 0; j < 8; ++j) { const int s = s0 + j;
                    const float wf = s <= li ? __expf(cfl - cfs[j]) * dtf[j] : 0.f, wb = s >= li ? __expf(cbl - cbs[j]) * dtb[j] : 0.f;
                    m[j] = cbv[j] * (wf + wb) + (s == li ? dskip : 0.f); }
            }
            u32x4 mw; mw.x = pk2(m[0], m[1]); mw.y = pk2(m[2], m[3]); mw.z = pk2(m[4], m[5]); mw.w = pk2(m[6], m[7]); mf[kk] = __builtin_bit_cast(bf16x8, mw);
        }
        float ssq = 0.f;
        const size_t grow = (size_t)(row0 + li);
#pragma unroll
        for (int jp = 0; jp < 4; ++jp) {
            const int ro = (16 * jp + fr) * 272 + 16 * fq;
            bf16x8 ax[4], af_[4], ab_[4];
#pragma unroll
            for (int kk = 0; kk < 4; ++kk) { ax[kk] = *(const LAS bf16x8*)(lx + ro + 64 * kk); af_[kk] = *(const LAS bf16x8*)(lhf + ro + 64 * kk); ab_[kk] = *(const LAS bf16x8*)(lhb + ro + 64 * kk); }
            f32x4 acc = {0.f, 0.f, 0.f, 0.f}, acc1 = acc, acc2 = acc;
#pragma unroll
            for (int kk = 0; kk < 4; ++kk) {
                acc = mfma16(ax[kk], mf[kk], acc);
                acc1 = mfma16(af_[kk], __builtin_bit_cast(bf16x8, ccv[kk]), acc1);
                acc2 = mfma16(ab_[kk], __builtin_bit_cast(bf16x8, ccv[kk]), acc2);
            }
            acc = acc + acc1 * ef + acc2 * eb;
            const int p = 16 * jp + 4 * fq;
            const u32x2 zw = cz[jp];
            const float y0 = acc[0] * pg8::silu_fast(bflo(zw.x)), y1 = acc[1] * pg8::silu_fast(bfhi(zw.x)), y2 = acc[2] * pg8::silu_fast(bflo(zw.y)), y3 = acc[3] * pg8::silu_fast(bfhi(zw.y));
            ssq += (y0 * y0 + y1 * y1) + (y2 * y2 + y3 * y3);
            u32x2 o; o.x = pk2(y0, y1); o.y = pk2(y2, y3);
            *(u32x2*)(YG + grow * 1024 + h * 64 + p) = o;
        }
        ssq += __shfl_xor(ssq, 16); ssq += __shfl_xor(ssq, 32);
        if (fq == 0) SSQ[grow * 16 + h] = ssq;
        if (un < NU) SC_STORE(F.lds + (cur ^ 1) * SETB);
        __syncthreads();
        u = un; cur ^= 1;
    }
#undef SC_VALID
#undef SC_LOAD
#undef SC_STORE
}

struct KArgs { const float* in[26]; float* out; unsigned char* ws; int lo, hi; };
constexpr int N_STEPS = 2 + 8 * 3 + 4 * 8 + 1;

__global__ void __launch_bounds__(NWAVES * 64, 2) mk_fwd(KArgs args) {
    extern __shared__ __attribute__((aligned(16))) unsigned char lds_raw[];
    Frame F0;
    F0.lds = (LAS unsigned char*)lds_raw;
    F0.tid = threadIdx.x; F0.lane = F0.tid & 63; F0.wave = __builtin_amdgcn_readfirstlane(F0.tid >> 6);
    F0.G = gridDim.x; { const int bx = blockIdx.x; F0.vcu = (F0.G % 8 == 0) ? (bx % 8) * (F0.G / 8) + bx / 8 : bx; }
    F0.out = args.out; F0.ws = args.ws;
    for (int u = F0.tid; u < (LDS_BYTES - LDSCTL_OFF) / 4; u += NWAVES * 64) ((LAS unsigned*)(F0.lds + LDSCTL_OFF))[u] = 0u;
    __syncthreads();
    if (F0.tid < 26) *(LAS unsigned long long*)(F0.lds + PTAB_OFF + 8 * F0.tid) = (unsigned long long)args.in[F0.tid];
    __syncthreads();
    volatile LAS unsigned* MISC = (volatile LAS unsigned*)(F0.lds + MISC_OFF);
    XcdBarrier bar; bar.bar = ((unsigned*)(F0.ws + WS_CTL)) + CW_BAR; bar.x = 0; bar.st = nullptr;
#if ONE_LAUNCH
    bar = xcd_barrier_post(((unsigned*)(F0.ws + WS_CTL)) + CW_BAR, MISC + 8);
#endif
    const int lo = args.lo, hi = args.hi;
    int step = 0;
#ifndef ONLY
#define ONLY (-1)
#endif
#define SEL(id) (ONLY < 0 || ONLY == (id))
#ifndef PROBE_SET
#define PROBE_SET 0
#endif
#ifndef PROBE_BAR
#define PROBE_BAR 0
#endif
#ifndef PROBE_SUB
#define PROBE_SUB 0
#endif
#define SUBREP(b) (1 + ((PROBE_SUB >> (b)) & 1))
#define NREP(id) (1 + ((PROBE_SET >> (id)) & 1))
#if ONE_LAUNCH
#define STEP(id, ...) do { if (SEL(id) && step >= lo && step < hi) { for (int rep = 0; rep < NREP(id); ++rep) { const Frame F = fresh(F0); __VA_ARGS__; } if (step + 1 < hi) { XcdBarrier b2 = bar; asm volatile("" : "+s"(b2.bar)); xcd_barrier(b2); if (PROBE_BAR) xcd_barrier(b2); } } ++step; } while (0)
#else
#define STEP(id, ...) do { if (SEL(id) && step >= lo && step < hi) { for (int rep = 0; rep < NREP(id); ++rep) { const Frame F = fresh(F0); __VA_ARGS__; } } ++step; } while (0)
#endif
    STEP(0, ph_prologue(F));
    STEP(1, ph_modfinal(F));
    for (int i = 0; i < 8; ++i) {
        const int l = i >> 1, f = i & 1;

        if (f == 1) {

            STEP(2, ph_norm(F, l, 1, l, rep ? -1 : 2, 0.5f, MT));
            STEP(3, ph_gemm_bf16(F, pg8::Gemm{((bf16*)(F.ws + WS_U)), ((bf16*)(F.ws + WS_WIN)) + (size_t)l * DINP * D, D, D, D}, pg8::EpiBf16{((bf16*)(F.ws + WS_P)), DINP, nullptr, nullptr, 0}, MT, DINP, 0, (rep == 0) ? 0 : -1, l < DEPTH - 1 ? 2 * l + 2 : 7, (l < DEPTH - 1 && rep == 0) ? 2 : -1, l + 1, (l == 0 && rep == 0) ? 4 : -1, 1));
            STEP(4, { for (int q = 0; q < SUBREP(0); ++q) ph_conv(F, l); for (int q = 0; q < SUBREP(1); ++q) ph_prep(F, l); ph_dtcum(F, l); });
            STEP(5, { { const bf16* Pp = ((bf16*)(F.ws + WS_P)); const float* rstd = ((float*)(F.ws + WS_RSTD)); ph_gemm_bf16(F, pg8::Gemm{Pp + PC_CQ, ((bf16*)(F.ws + WS_WUQ)) + (size_t)l * 768 * 384, DINP, 384, 384}, pg8::EpiBf16{((bf16*)(F.ws + WS_QM)), 768, rstd, nullptr, 0}, MT, 768);
                      ph_gemm_bf16(F, pg8::Gemm{Pp + PC_CKV, ((bf16*)(F.ws + WS_WUK)) + (size_t)l * 512 * 256, DINP, 256, 256}, pg8::EpiBf16{((bf16*)(F.ws + WS_KM)), 768, rstd + MT, nullptr, 1}, MT, 512, 52);
                      ph_gemm_bf16(F, pg8::Gemm{((bf16*)(F.ws + WS_WUV)) + (size_t)l * 512 * 256, Pp + PC_CKV, 256, DINP, 256}, pg8::EpiBf16{((bf16*)(F.ws + WS_VT)), MT, nullptr, rstd + MT, 0}, 512, MT, 172);
                      } for (int q = 0; q < SUBREP(3); ++q) ph_ssd_a(F, l); });
            STEP(6, { if (rep == 0) ph_ssd_scan(F); ph_attn(F, l); });
            STEP(13, { for (int q = 0; q < SUBREP(4); ++q) ph_ssd_c(F, l); });
            STEP(7, { for (int q = 0; q < SUBREP(5); ++q) ph_outnorm(F, l); });
            STEP(8, ph_gemm_resid(F, pg8::Gemm{((bf16*)(F.ws + WS_OX)), ((bf16*)(F.ws + WS_WOUT)) + (size_t)l * D * D, D, D, D}, pg8::EpiResid{((bf16*)(F.ws + WS_H)), ((float*)(F.ws + WS_MODV)) + (size_t)l * 5 * NMODV, 5, rep ? 0.0f : 1.0f, D / 64, ((bf16*)(F.ws + WS_PART))}, l != DEPTH - 1));
        }
        STEP(9, ph_norm(F, l, f ? 2 : 0, f ? l : l - 1, rep ? -1 : (f ? 5 : (l > 0 ? 8 : -1)), f ? 1.0f : 0.5f, (l == DEPTH - 1 && f) ? ML : MT));
        STEP(10, ph_gemm_swiglu(F, pg8::Gemm{((bf16*)(F.ws + WS_U)), ((bf16*)(F.ws + WS_WGU)) + (size_t)i * 11264 * D, D, D, D}, pg8::EpiSwiGLU{((bf16*)(F.ws + WS_HID)), DFF}, (l == DEPTH - 1 && f) ? ML : MT, 11264, (i < 7 && rep == 0) ? 1 : -1, i + 1, (i <= 4 && rep == 0) ? ((i & 1) || i == 0 ? 3 : 4) : -1, i == 0 ? 1 : i <= 2 ? 3 : 5));
        STEP(11, ph_gemm_resid(F, pg8::Gemm{((bf16*)(F.ws + WS_HID)), ((bf16*)(F.ws + WS_WD)) + (size_t)i * D * DFF, DFF, DFF, DFF}, pg8::EpiResid{((bf16*)(F.ws + WS_H)), ((float*)(F.ws + WS_MODV)) + (size_t)l * 5 * NMODV, f ? 8 : 2, rep ? 0.0f : 0.5f, DFF / 64, ((bf16*)(F.ws + WS_PART))}, !(l == DEPTH - 1 && f)));
    }
    STEP(12, ph_final(F));
#undef STEP
}

extern "C" void kernel_launch(void* const* d_in, const int* in_sizes, int n_in, void* d_out, int out_size, void* d_ws, size_t ws_size, hipStream_t stream) {
    static int grid = 0;
    if (grid == 0) {
        if (n_in != 26 || out_size != ML * D || ws_size < WS_END) { fprintf(stderr, "kernel_launch: unexpected shapes (n_in %d out %d ws %zu)\n", n_in, out_size, ws_size); grid = -1; return; }
        int dev = 0, cus = 0, per_cu = 0;
        if (hipGetDevice(&dev) != hipSuccess || hipDeviceGetAttribute(&cus, hipDeviceAttributeMultiprocessorCount, dev) != hipSuccess) { grid = -1; return; }
        if (hipFuncSetAttribute((const void*)mk_fwd, hipFuncAttributeMaxDynamicSharedMemorySize, LDS_BYTES) != hipSuccess) { fprintf(stderr, "kernel_launch: hipFuncSetAttribute failed\n"); grid = -1; return; }
        if (hipOccupancyMaxActiveBlocksPerMultiprocessor(&per_cu, (const void*)mk_fwd, NWAVES * 64, LDS_BYTES) != hipSuccess || per_cu < 1)
            fprintf(stderr, "kernel_launch: occupancy query reports %d\n", per_cu);
        (void)hipGetLastError();
        grid = cus;
    }
    if (grid <= 0) return;
    hipMemsetAsync((unsigned char*)d_ws + WS_CTL, 0, CTL_ZERO_BYTES, stream);
    KArgs a{};
    for (int i = 0; i < 26; ++i) a.in[i] = (const float*)d_in[i];
    a.out = (float*)d_out; a.ws = (unsigned char*)d_ws;
#if ONE_LAUNCH
    a.lo = 0; a.hi = N_STEPS;
    hipLaunchKernelGGL(mk_fwd, dim3(grid), dim3(NWAVES * 64), LDS_BYTES, stream, a);
#else
    for (int s = 0; s < N_STEPS; ++s) { a.lo = s; a.hi = s + 1; hipLaunchKernelGGL(mk_fwd, dim3(grid), dim3(NWAVES * 64), LDS_BYTES, stream, a); }
#endif
}
```

```cpp
#include <hip/hip_runtime.h>
#include <cstdio>
#include <cstdint>

#define GAS __attribute__((address_space(1)))
#define LAS __attribute__((address_space(3)))
typedef unsigned short bf16;
typedef short bf16x8 __attribute__((ext_vector_type(8)));
typedef float f32x4 __attribute__((ext_vector_type(4)));
typedef float f32x2 __attribute__((ext_vector_type(2)));
typedef unsigned u32x4 __attribute__((ext_vector_type(4)));
typedef unsigned u32x2 __attribute__((ext_vector_type(2)));

#ifndef ONE_LAUNCH
#define ONE_LAUNCH 1
#define PROBE_SET 0
#define PROBE_SUB 0
#endif

constexpr int D = 2048, NB = 4, SEQ = 4096, DEPTH = 4, CTX = 256, DFF = 5632, NMODV = 9 * 2048;
constexpr int ML = NB * SEQ, MC = NB * CTX, MT = ML + MC;
constexpr int DIN = 4032, DINP = 4096;
constexpr int PC_Z = 0, PC_XBC = 1024, PC_DT = 2560, PC_CQ = 2592, PC_CKV = 2976, PC_KR = 3232, PC_QS = 3264, PC_KS = 3776, PC_VS = 3904;
constexpr float EPS = 1e-6f;
constexpr float LOG2E = 1.4426950408889634f;

constexpr size_t MiB = 1u << 20;
constexpr size_t WS_CTL = 0, CTL_ZERO_BYTES = 64 * 1024;
constexpr size_t WS_MODP = 1 * MiB;
constexpr size_t WS_MODV = 13 * MiB;
constexpr size_t WS_WGU = 16 * MiB;
constexpr size_t WS_WD = 368 * MiB;
constexpr size_t WS_WIN = 544 * MiB;
constexpr size_t WS_WOUT = 608 * MiB;
constexpr size_t WS_WUQ = 640 * MiB;
constexpr size_t WS_WUK = 643 * MiB;
constexpr size_t WS_WUV = 644 * MiB;
constexpr size_t WS_RSTD = 645 * MiB;
constexpr size_t WS_DT = 646 * MiB;
constexpr size_t WS_H = 652 * MiB;
constexpr size_t WS_U = 788 * MiB;
constexpr size_t WS_OX = 856 * MiB;
constexpr size_t WS_P = 924 * MiB;
constexpr size_t WS_HID = 1060 * MiB;
constexpr size_t WS_XS = 1247 * MiB;
constexpr size_t WS_BC = 1281 * MiB;
constexpr size_t WS_QM = 1298 * MiB;
constexpr size_t WS_KM = 1324 * MiB;
constexpr size_t WS_VT = 1350 * MiB;
constexpr size_t WS_KS = 1367 * MiB;
constexpr size_t WS_VST = 1372 * MiB;
constexpr size_t WS_MX = 1377 * MiB;
constexpr size_t WS_SX = 1411 * MiB;
constexpr size_t WS_ST = 1445 * MiB;
constexpr size_t WS_BT = 1513 * MiB;
constexpr size_t WS_CB = 1522 * MiB;
constexpr size_t WS_CUM = 1531 * MiB;
constexpr size_t WS_DEC = 1536 * MiB;
constexpr size_t WS_YG = 1537 * MiB;
constexpr size_t WS_SSQ = 1571 * MiB;
constexpr size_t WS_PART = 1573 * MiB;
constexpr size_t WS_END = 1637 * MiB;
constexpr int CW_BAR = 4096;

constexpr int RING_BYTES = 131072;
constexpr int LDSCTL_OFF = RING_BYTES, MISC_OFF = LDSCTL_OFF + 320;
constexpr int LDS_BYTES = 147456;
constexpr int NWAVES = 8;

#define RLX_AGENT __ATOMIC_RELAXED, __HIP_MEMORY_SCOPE_AGENT
#define LDS_WAIT() asm volatile("s_waitcnt lgkmcnt(0)" ::: "memory")
#define VM_WAIT() asm volatile("s_waitcnt vmcnt(0)" ::: "memory")

typedef __bf16 bf16x2_t __attribute__((ext_vector_type(2)));
__device__ __forceinline__ unsigned pk2(float lo, float hi) { const f32x2 v = {lo, hi}; return __builtin_bit_cast(unsigned, __builtin_convertvector(v, bf16x2_t)); }
__device__ __forceinline__ unsigned f2bf(float f) { return pk2(f, 0.f) & 0xffffu; }
__device__ __forceinline__ float bf2f(bf16 b) { return __builtin_bit_cast(float, (unsigned)b << 16); }
__device__ __forceinline__ float bflo(unsigned w) { return __builtin_bit_cast(float, w << 16); }
__device__ __forceinline__ float bfhi(unsigned w) { return __builtin_bit_cast(float, w & 0xffff0000u); }
__device__ __forceinline__ float wave_sum(float v) {
#pragma unroll
    for (int o = 1; o < 64; o <<= 1) v += __shfl_xor(v, o);
    return v;
}
__device__ __forceinline__ float wave_max(float v) {
#pragma unroll
    for (int o = 1; o < 64; o <<= 1) v = fmaxf(v, __shfl_xor(v, o));
    return v;
}
__device__ __forceinline__ float silu_f(float x) { return x / (1.f + __expf(-x)); }

__device__ const float ROPE_COS_8[512] = { 1.00000000e+00f, 1.00000000e+00f, 1.00000000e+00f, 1.00000000e+00f, 1.00000000e+00f, 1.00000000e+00f, 1.00000000e+00f, 1.00000000e+00f, 5.40302277e-01f, 9.50415254e-01f, 9.95004177e-01f, 9.99500036e-01f, 9.99949992e-01f, 9.99994993e-01f, 9.99999523e-01f, 9.99999940e-01f, -4.16146845e-01f, 8.06578398e-01f, 9.80066597e-01f, 9.98000681e-01f, 9.99800026e-01f, 9.99979973e-01f, 9.99997973e-01f, 9.99999821e-01f, -9.89992499e-01f, 5.82753658e-01f, 9.55336511e-01f, 9.95503366e-01f, 9.99550045e-01f, 9.99954998e-01f, 9.99995530e-01f, 9.99999523e-01f, -6.53643608e-01f, 3.01137477e-01f, 9.21060979e-01f, 9.92010653e-01f, 9.99200106e-01f, 9.99920011e-01f, 9.99992013e-01f, 9.99999225e-01f, 2.83662200e-01f, -1.03423381e-02f, 8.77582550e-01f, 9.87526000e-01f, 9.98750269e-01f, 9.99875009e-01f, 9.99987483e-01f, 9.99998748e-01f, 9.60170269e-01f, -3.20796400e-01f, 8.25335622e-01f, 9.82053936e-01f, 9.98200536e-01f, 9.99819994e-01f, 9.99981999e-01f, 9.99998212e-01f, 7.53902256e-01f, -5.99437475e-01f, 7.64842212e-01f, 9.75599885e-01f, 9.97551024e-01f, 9.99755025e-01f, 9.99975502e-01f, 9.99997556e-01f, -1.45500034e-01f, -8.18632424e-01f, 6.96706712e-01f, 9.68170285e-01f, 9.96801734e-01f, 9.99680042e-01f, 9.99967992e-01f, 9.99996781e-01f, -9.11130250e-01f, -9.56644177e-01f, 6.21609926e-01f, 9.59772646e-01f, 9.95952725e-01f, 9.99595046e-01f, 9.99959528e-01f, 9.99995947e-01f, -8.39071512e-01f, -9.99786079e-01f, 5.40302277e-01f, 9.50415313e-01f, 9.95004177e-01f, 9.99500036e-01f, 9.99949992e-01f, 9.99994993e-01f, 4.42569796e-03f, -9.43779767e-01f, 4.53596085e-01f, 9.40107584e-01f, 9.93956089e-01f, 9.99395072e-01f, 9.99939501e-01f, 9.99993920e-01f, 8.43853951e-01f, -7.94179380e-01f, 3.62357706e-01f, 9.28859890e-01f, 9.92808640e-01f, 9.99280095e-01f, 9.99927998e-01f, 9.99992788e-01f, 9.07446802e-01f, -5.65820515e-01f, 2.67498761e-01f, 9.16683376e-01f, 9.91561890e-01f, 9.99155104e-01f, 9.99915481e-01f, 9.99991536e-01f, 1.36737213e-01f, -2.81349480e-01f, 1.69967160e-01f, 9.03590262e-01f, 9.90216017e-01f, 9.99020159e-01f, 9.99902010e-01f, 9.99990225e-01f, -7.59687901e-01f, 3.10223512e-02f, 7.07371980e-02f, 8.89593601e-01f, 9.88771081e-01f, 9.98875201e-01f, 9.99887526e-01f, 9.99988735e-01f, -9.57659483e-01f, 3.40318173e-01f, -2.91995462e-02f, 8.74707460e-01f, 9.87227261e-01f, 9.98720288e-01f, 9.99872029e-01f, 9.99987185e-01f, -2.75163352e-01f, 6.15864813e-01f, -1.28844544e-01f, 8.58946681e-01f, 9.85584795e-01f, 9.98555362e-01f, 9.99855518e-01f, 9.99985576e-01f, 6.60316706e-01f, 8.30336154e-01f, -2.27202162e-01f, 8.42327058e-01f, 9.83843684e-01f, 9.98380423e-01f, 9.99837995e-01f, 9.99983788e-01f, 9.88704622e-01f, 9.62463796e-01f, -3.23289543e-01f, 8.24865162e-01f, 9.82004225e-01f, 9.98195529e-01f, 9.99819517e-01f, 9.99981940e-01f, 4.08082068e-01f, 9.99144375e-01f, -4.16146845e-01f, 8.06578457e-01f, 9.80066597e-01f, 9.98000681e-01f, 9.99800026e-01f, 9.99979973e-01f, -5.47729254e-01f, 9.36740458e-01f, -5.04846215e-01f, 7.87485182e-01f, 9.78030920e-01f, 9.97795820e-01f, 9.99779522e-01f, 9.99977946e-01f, -9.99960840e-01f, 7.81440377e-01f, -5.88501155e-01f, 7.67604589e-01f, 9.75897431e-01f, 9.97581005e-01f, 9.99758005e-01f, 9.99975801e-01f, -5.32833040e-01f, 5.48645258e-01f, -6.66275978e-01f, 7.46956408e-01f, 9.73666370e-01f, 9.97356176e-01f, 9.99735534e-01f, 9.99973536e-01f, 4.24179018e-01f, 2.61441678e-01f, -7.37393796e-01f, 7.25561321e-01f, 9.71337974e-01f, 9.97121394e-01f, 9.99711990e-01f, 9.99971211e-01f, 9.91202831e-01f, -5.16893305e-02f, -8.01143587e-01f, 7.03440726e-01f, 9.68912423e-01f, 9.96876657e-01f, 9.99687493e-01f, 9.99968767e-01f, 6.46919310e-01f, -3.59694332e-01f, -8.56888831e-01f, 6.80616796e-01f, 9.66389954e-01f, 9.96621907e-01f, 9.99662042e-01f, 9.99966204e-01f, -2.92138815e-01f, -6.32028639e-01f, -9.04072165e-01f, 6.57112300e-01f, 9.63770926e-01f, 9.96357203e-01f, 9.99635518e-01f, 9.99963522e-01f, -9.62605894e-01f, -8.41684937e-01f, -9.42222297e-01f, 6.32950664e-01f, 9.61055458e-01f, 9.96082544e-01f, 9.99608040e-01f, 9.99960780e-01f, -7.48057544e-01f, -9.67871487e-01f, -9.70958173e-01f, 6.08156204e-01f, 9.58243906e-01f, 9.95797932e-01f, 9.99579549e-01f, 9.99957979e-01f, 1.54251456e-01f, -9.98075247e-01f, -9.89992499e-01f, 5.82753658e-01f, 9.55336511e-01f, 9.95503366e-01f, 9.99550045e-01f, 9.99954998e-01f, 9.14742351e-01f, -9.29300308e-01f, -9.99135137e-01f, 5.56768358e-01f, 9.52333570e-01f, 9.95198846e-01f, 9.99519527e-01f, 9.99951959e-01f, 8.34223390e-01f, -7.68367112e-01f, -9.98294771e-01f, 5.30226350e-01f, 9.49235439e-01f, 9.94884372e-01f, 9.99488056e-01f, 9.99948800e-01f, -1.32767474e-02f, -5.31235278e-01f, -9.87479806e-01f, 5.03154159e-01f, 9.46042359e-01f, 9.94559944e-01f, 9.99455571e-01f, 9.99945521e-01f, -8.48570287e-01f, -2.41421118e-01f, -9.66798186e-01f, 4.75578904e-01f, 9.42754686e-01f, 9.94225562e-01f, 9.99422073e-01f, 9.99942183e-01f, -9.03692186e-01f, 7.23346695e-02f, -9.36456680e-01f, 4.47528064e-01f, 9.39372718e-01f, 9.93881226e-01f, 9.99387562e-01f, 9.99938726e-01f, -1.27963692e-01f, 3.78916174e-01f, -8.96758378e-01f, 4.19029742e-01f, 9.35896814e-01f, 9.93526995e-01f, 9.99352098e-01f, 9.99935210e-01f, 7.65414059e-01f, 6.47921681e-01f, -8.48100007e-01f, 3.90112430e-01f, 9.32327330e-01f, 9.93162811e-01f, 9.99315560e-01f, 9.99931574e-01f, 9.55073655e-01f, 8.52673113e-01f, -7.90967762e-01f, 3.60805035e-01f, 9.28664625e-01f, 9.92788672e-01f, 9.99278069e-01f, 9.99927819e-01f, 2.66642928e-01f, 9.72865343e-01f, -7.25932240e-01f, 3.31136853e-01f, 9.24909055e-01f, 9.92404640e-01f, 9.99239624e-01f, 9.99923944e-01f, -6.66938066e-01f, 9.96578991e-01f, -6.53643608e-01f, 3.01137596e-01f, 9.21060979e-01f, 9.92010653e-01f, 9.99200106e-01f, 9.99920011e-01f, -9.87339258e-01f, 9.21462357e-01f, -5.74824035e-01f, 2.70837069e-01f, 9.17120814e-01f, 9.91606772e-01f, 9.99159634e-01f, 9.99915957e-01f, -3.99985313e-01f, 7.54965365e-01f, -4.90260571e-01f, 2.40265876e-01f, 9.13088918e-01f, 9.91192937e-01f, 9.99118149e-01f, 9.99911785e-01f, 5.55113316e-01f, 5.13598442e-01f, -4.00799006e-01f, 2.09454417e-01f, 9.08965766e-01f, 9.90769207e-01f, 9.99075651e-01f, 9.99907553e-01f, 9.99843299e-01f, 2.21298173e-01f, -3.07332784e-01f, 1.78433523e-01f, 9.04751658e-01f, 9.90335584e-01f, 9.99032140e-01f, 9.99903202e-01f, 5.25321960e-01f, -9.29481089e-02f, -2.10795805e-01f, 1.47234216e-01f, 9.00447130e-01f, 9.89892066e-01f, 9.98987675e-01f, 9.99898732e-01f, -4.32177931e-01f, -3.97976756e-01f, -1.12152621e-01f, 1.15887694e-01f, 8.96052480e-01f, 9.89438653e-01f, 9.98942196e-01f, 9.99894202e-01f, -9.92335498e-01f, -6.63538277e-01f, -1.23883775e-02f, 8.44252855e-02f, 8.91568303e-01f, 9.88975346e-01f, 9.98895705e-01f, 9.99889553e-01f, -6.40144348e-01f, -8.63296509e-01f, 8.74991715e-02f, 5.28784581e-02f, 8.86994898e-01f, 9.88502085e-01f, 9.98848200e-01f, 9.99884784e-01f, 3.00592542e-01f, -9.77442741e-01f, 1.86512470e-01f, 2.12787576e-02f, 8.82332861e-01f, 9.88018990e-01f, 9.98799741e-01f, 9.99879956e-01f, 9.64965999e-01f, -9.94656444e-01f, 2.83662200e-01f, -1.03422189e-02f, 8.77582550e-01f, 9.87526000e-01f, 9.98750269e-01f, 9.99875009e-01f, 7.42154181e-01f, -9.13230121e-01f, 3.77977669e-01f, -4.19528559e-02f, 8.72744501e-01f, 9.87023175e-01f, 9.98699784e-01f, 9.99869943e-01f, -1.62990779e-01f, -7.41239965e-01f, 4.68516916e-01f, -7.35215396e-02f, 8.67819190e-01f, 9.86510456e-01f, 9.98648286e-01f, 9.99864817e-01f, -9.18282807e-01f, -4.95741814e-01f, 5.54374516e-01f, -1.05016708e-01f, 8.62807095e-01f, 9.85987842e-01f, 9.98595834e-01f, 9.99859571e-01f, -8.29309821e-01f, -2.01079622e-01f, 6.34692967e-01f, -1.36406869e-01f, 8.57708693e-01f, 9.85455394e-01f, 9.98542368e-01f, 9.99854207e-01f, 2.21267566e-02f, 1.13521777e-01f, 7.08669782e-01f, -1.67660639e-01f, 8.52524519e-01f, 9.84913111e-01f, 9.98487890e-01f, 9.99848783e-01f, 8.53220105e-01f, 4.16867077e-01f, 7.75565803e-01f, -1.98746875e-01f, 8.47255111e-01f, 9.84360933e-01f, 9.98432398e-01f, 9.99843180e-01f, 8.99866819e-01f, 6.78870201e-01f, 8.34712923e-01f, -2.29634270e-01f, 8.41901004e-01f, 9.83798921e-01f, 9.98375952e-01f, 9.99837577e-01f, 1.19180135e-01f, 8.73550534e-01f, 8.85519624e-01f, -2.60292053e-01f, 8.36462677e-01f, 9.83227074e-01f, 9.98318493e-01f, 9.99831796e-01f, -7.71080196e-01f, 9.81602073e-01f, 9.27478492e-01f, -2.90689558e-01f, 8.30940723e-01f, 9.82645452e-01f, 9.98260021e-01f, 9.99825954e-01f, -9.52412963e-01f, 9.92308319e-01f, 9.60170269e-01f, -3.20796400e-01f, 8.25335622e-01f, 9.82053936e-01f, 9.98200536e-01f, 9.99819994e-01f, -2.58101642e-01f, 9.04607594e-01f, 9.83268440e-01f, -3.50582451e-01f, 8.19648027e-01f, 9.81452644e-01f, 9.98140097e-01f, 9.99813974e-01f, 6.73507154e-01f, 7.27198064e-01f, 9.96542096e-01f, -3.80017966e-01f, 8.13878477e-01f, 9.80841517e-01f, 9.98078644e-01f, 9.99807835e-01f, 9.85896587e-01f, 4.77671444e-01f, 9.99858618e-01f, -4.09073502e-01f, 8.08027506e-01f, 9.80220556e-01f, 9.98016179e-01f, 9.99801576e-01f };
__device__ const float ROPE_SIN_8[512] = { 0.00000000e+00f, 0.00000000e+00f, 0.00000000e+00f, 0.00000000e+00f, 0.00000000e+00f, 0.00000000e+00f, 0.00000000e+00f, 0.00000000e+00f, 8.41470957e-01f, 3.10983598e-01f, 9.98334214e-02f, 3.16175036e-02f, 9.99983307e-03f, 3.16227227e-03f, 9.99999931e-04f, 3.16227757e-04f, 9.09297407e-01f, 5.91127098e-01f, 1.98669329e-01f, 6.32033944e-02f, 1.99986659e-02f, 6.32451288e-03f, 1.99999870e-03f, 6.32455456e-04f, 1.41120002e-01f, 8.12648892e-01f, 2.95520216e-01f, 9.47260857e-02f, 2.99954992e-02f, 9.48669016e-03f, 2.99999560e-03f, 9.48683126e-04f, -7.56802499e-01f, 9.53580737e-01f, 3.89418334e-01f, 1.26154065e-01f, 3.99893336e-02f, 1.26487734e-02f, 3.99998948e-03f, 1.26491068e-03f, -9.58924294e-01f, 9.99946535e-01f, 4.79425550e-01f, 1.57455876e-01f, 4.99791652e-02f, 1.58107281e-02f, 4.99997940e-03f, 1.58113812e-03f, -2.79415488e-01f, 9.47148204e-01f, 5.64642489e-01f, 1.88600272e-01f, 5.99640049e-02f, 1.89725272e-02f, 5.99996420e-03f, 1.89736532e-03f, 6.56986594e-01f, 8.00421596e-01f, 6.44217670e-01f, 2.19556093e-01f, 6.99428469e-02f, 2.21341345e-02f, 6.99994294e-03f, 2.21359241e-03f, 9.89358246e-01f, 5.74317753e-01f, 7.17356086e-01f, 2.50292331e-01f, 7.99146891e-02f, 2.52955221e-02f, 7.99991470e-03f, 2.52981926e-03f, 4.12118495e-01f, 2.91259229e-01f, 7.83326924e-01f, 2.80778319e-01f, 8.98785442e-02f, 2.84566563e-02f, 8.99987947e-03f, 2.84604589e-03f, -5.44021130e-01f, -2.06835698e-02f, 8.41470957e-01f, 3.10983568e-01f, 9.98334140e-02f, 3.16175036e-02f, 9.99983400e-03f, 3.16227227e-03f, -9.99990225e-01f, -3.30574960e-01f, 8.91207397e-01f, 3.40877861e-01f, 1.09778300e-01f, 3.47780399e-02f, 1.09997792e-02f, 3.47849843e-03f, -5.36572933e-01f, -6.07683420e-01f, 9.32039082e-01f, 3.70431304e-01f, 1.19712204e-01f, 3.79382223e-02f, 1.19997123e-02f, 3.79472389e-03f, 4.20167029e-01f, -8.24528456e-01f, 9.63558197e-01f, 3.99614304e-01f, 1.29634142e-01f, 4.10980321e-02f, 1.29996343e-02f, 4.11094911e-03f, 9.90607381e-01f, -9.59605396e-01f, 9.85449731e-01f, 4.28397775e-01f, 1.39543116e-01f, 4.42574248e-02f, 1.39995432e-02f, 4.42717411e-03f, 6.50287867e-01f, -9.99518692e-01f, 9.97494996e-01f, 4.56752867e-01f, 1.49438128e-01f, 4.74163815e-02f, 1.49994381e-02f, 4.74339863e-03f, -2.87903309e-01f, -9.40310359e-01f, 9.99573588e-01f, 4.84651238e-01f, 1.59318209e-01f, 5.05748577e-02f, 1.59993190e-02f, 5.05962269e-03f, -9.61397469e-01f, -7.87851870e-01f, 9.91664827e-01f, 5.12064993e-01f, 1.69182345e-01f, 5.37328273e-02f, 1.69991814e-02f, 5.37584582e-03f, -7.50987232e-01f, -5.57262897e-01f, 9.73847628e-01f, 5.38966715e-01f, 1.79029569e-01f, 5.68902642e-02f, 1.79990288e-02f, 5.69206895e-03f, 1.49877205e-01f, -2.71410108e-01f, 9.46300089e-01f, 5.65329552e-01f, 1.88858896e-01f, 6.00471310e-02f, 1.89988576e-02f, 6.00829115e-03f, 9.12945271e-01f, 4.13582884e-02f, 9.09297407e-01f, 5.91127038e-01f, 1.98669314e-01f, 6.32033944e-02f, 1.99986678e-02f, 6.32451288e-03f, 8.36655617e-01f, 3.50024760e-01f, 8.63209307e-01f, 6.16333544e-01f, 2.08459899e-01f, 6.63590282e-02f, 2.09984574e-02f, 6.64073415e-03f, -8.85130931e-03f, 6.23979926e-01f, 8.08496356e-01f, 6.40923738e-01f, 2.18229622e-01f, 6.95140064e-02f, 2.19982266e-02f, 6.95695449e-03f, -8.46220434e-01f, 8.36055279e-01f, 7.45705247e-01f, 6.64873064e-01f, 2.27977514e-01f, 7.26682767e-02f, 2.29979735e-02f, 7.27317436e-03f, -9.05578375e-01f, 9.65219259e-01f, 6.75463140e-01f, 6.88157499e-01f, 2.37702623e-01f, 7.58218244e-02f, 2.39976961e-02f, 7.58939330e-03f, -1.32351756e-01f, 9.98663187e-01f, 5.98472118e-01f, 7.10753918e-01f, 2.47403964e-01f, 7.89746121e-02f, 2.49973964e-02f, 7.90561177e-03f, 7.62558460e-01f, 9.33070183e-01f, 5.15501261e-01f, 7.32639611e-01f, 2.57080555e-01f, 8.21266174e-02f, 2.59970706e-02f, 8.22182931e-03f, 9.56375957e-01f, 7.74945021e-01f, 4.27379847e-01f, 7.53792703e-01f, 2.66731411e-01f, 8.52777958e-02f, 2.69967206e-02f, 8.53804592e-03f, 2.70905793e-01f, 5.39968967e-01f, 3.34988207e-01f, 7.74192095e-01f, 2.76355654e-01f, 8.84281173e-02f, 2.79963426e-02f, 8.85426160e-03f, -6.63633883e-01f, 2.51445323e-01f, 2.39249229e-01f, 7.93817401e-01f, 2.85952210e-01f, 9.15775672e-02f, 2.89959367e-02f, 9.17047635e-03f, -9.88031626e-01f, -6.20148405e-02f, 1.41120002e-01f, 8.12648892e-01f, 2.95520186e-01f, 9.47260931e-02f, 2.99955010e-02f, 9.48669016e-03f, -4.04037654e-01f, -3.69325012e-01f, 4.15805206e-02f, 8.30667794e-01f, 3.05058628e-01f, 9.78736654e-02f, 3.09950355e-02f, 9.80290305e-03f, 5.51426709e-01f, -6.40009403e-01f, -5.83741926e-02f, 8.47856104e-01f, 3.14566553e-01f, 1.01020269e-01f, 3.19945402e-02f, 1.01191159e-02f, 9.99911845e-01f, -8.47224355e-01f, -1.57745644e-01f, 8.64196658e-01f, 3.24043006e-01f, 1.04165860e-01f, 3.29940096e-02f, 1.04353270e-02f, 5.29082716e-01f, -9.70420420e-01f, -2.55541205e-01f, 8.79673064e-01f, 3.33487093e-01f, 1.07310407e-01f, 3.39934528e-02f, 1.07515370e-02f, -4.28182662e-01f, -9.97380435e-01f, -3.50783229e-01f, 8.94269884e-01f, 3.42897803e-01f, 1.10453881e-01f, 3.49928550e-02f, 1.10677453e-02f, -9.91778851e-01f, -9.25431013e-01f, -4.42520559e-01f, 9.07972515e-01f, 3.52274209e-01f, 1.13596253e-01f, 3.59922275e-02f, 1.13839535e-02f, -6.43538117e-01f, -7.61706948e-01f, -5.29836178e-01f, 9.20767248e-01f, 3.61615449e-01f, 1.16737492e-01f, 3.69915590e-02f, 1.17001599e-02f, 2.96368569e-01f, -5.22444785e-01f, -6.11857831e-01f, 9.32641268e-01f, 3.70920479e-01f, 1.19877554e-01f, 3.79908569e-02f, 1.20163653e-02f, 9.63795364e-01f, -2.31372014e-01f, -6.87766254e-01f, 9.43582714e-01f, 3.80188406e-01f, 1.23016424e-01f, 3.89901139e-02f, 1.23325698e-02f, 7.45113134e-01f, 8.26458037e-02f, -7.56802499e-01f, 9.53580678e-01f, 3.89418334e-01f, 1.26154065e-01f, 3.99893373e-02f, 1.26487734e-02f, -1.58622667e-01f, 3.88467699e-01f, -8.18277061e-01f, 9.62625206e-01f, 3.98609310e-01f, 1.29290432e-01f, 4.09885161e-02f, 1.29649751e-02f, -9.16521549e-01f, 6.55764699e-01f, -8.71575892e-01f, 9.70707119e-01f, 4.07760441e-01f, 1.32425532e-01f, 4.19876575e-02f, 1.32811759e-02f, -8.31774771e-01f, 8.58030677e-01f, -9.16166008e-01f, 9.77818429e-01f, 4.16870773e-01f, 1.35559291e-01f, 4.29867506e-02f, 1.35973748e-02f, 1.77019257e-02f, 9.75206196e-01f, -9.51602101e-01f, 9.83951986e-01f, 4.25939471e-01f, 1.38691694e-01f, 4.39858064e-02f, 1.39135728e-02f, 8.50903511e-01f, 9.95670974e-01f, -9.77530122e-01f, 9.89101648e-01f, 4.34965521e-01f, 1.41822711e-01f, 4.49848175e-02f, 1.42297689e-02f, 9.01788354e-01f, 9.17395473e-01f, -9.93690968e-01f, 9.93262351e-01f, 4.43948090e-01f, 1.44952312e-01f, 4.59837839e-02f, 1.45459641e-02f, 1.23573124e-01f, 7.48142362e-01f, -9.99923289e-01f, 9.96429801e-01f, 4.52886283e-01f, 1.48080453e-01f, 4.69827019e-02f, 1.48621574e-02f, -7.68254638e-01f, 5.04697084e-01f, -9.96164620e-01f, 9.98600960e-01f, 4.61779177e-01f, 1.51207119e-01f, 4.79815714e-02f, 1.51783489e-02f, -9.53752637e-01f, 2.11200655e-01f, -9.82452571e-01f, 9.99773562e-01f, 4.70625877e-01f, 1.54332280e-01f, 4.89803962e-02f, 1.54945394e-02f, -2.62374848e-01f, -1.03240460e-01f, -9.58924294e-01f, 9.99946535e-01f, 4.79425550e-01f, 1.57455891e-01f, 4.99791689e-02f, 1.58107281e-02f, 6.70229197e-01f, -4.07444149e-01f, -9.25814748e-01f, 9.99119580e-01f, 4.88177240e-01f, 1.60577938e-01f, 5.09778969e-02f, 1.61269177e-02f, 9.86627579e-01f, -6.71240151e-01f, -8.83454502e-01f, 9.97293651e-01f, 4.96880114e-01f, 1.63698375e-01f, 5.19765690e-02f, 1.64431017e-02f, 3.95925164e-01f, -8.68469954e-01f, -8.32267344e-01f, 9.94470477e-01f, 5.05533338e-01f, 1.66817173e-01f, 5.29751927e-02f, 1.67592876e-02f, -5.58789074e-01f, -9.79574919e-01f, -7.72764444e-01f, 9.90652919e-01f, 5.14135957e-01f, 1.69934288e-01f, 5.39737605e-02f, 1.70754679e-02f, -9.99755144e-01f, -9.93535519e-01f, -7.05540299e-01f, 9.85844791e-01f, 5.22687256e-01f, 1.73049718e-01f, 5.49722798e-02f, 1.73916500e-02f, -5.21551013e-01f, -9.08967435e-01f, -6.31266713e-01f, 9.80050862e-01f, 5.31186223e-01f, 1.76163420e-01f, 5.59707358e-02f, 1.77078284e-02f, 4.36164767e-01f, -7.34258294e-01f, -5.50685287e-01f, 9.73276973e-01f, 5.39632022e-01f, 1.79275364e-01f, 5.69691435e-02f, 1.80240069e-02f, 9.92872655e-01f, -4.86733496e-01f, -4.64602023e-01f, 9.65529919e-01f, 5.48023939e-01f, 1.82385504e-01f, 5.79674877e-02f, 1.83401816e-02f, 6.36738002e-01f, -1.90938011e-01f, -3.73876572e-01f, 9.56817448e-01f, 5.56361020e-01f, 1.85493827e-01f, 5.89657798e-02f, 1.86563563e-02f, -3.04810613e-01f, 1.23790950e-01f, -2.79415488e-01f, 9.47148204e-01f, 5.64642429e-01f, 1.88600287e-01f, 5.99640086e-02f, 1.89725272e-02f, -9.66117799e-01f, 4.26245421e-01f, -1.82162598e-01f, 9.36531842e-01f, 5.72867453e-01f, 1.91704854e-01f, 6.09621815e-02f, 1.92886982e-02f, -7.39180684e-01f, 6.86427653e-01f, -8.30891207e-02f, 9.24979091e-01f, 5.81035137e-01f, 1.94807529e-01f, 6.19602874e-02f, 1.96048655e-02f, 1.67355701e-01f, 8.78538549e-01f, 1.68140903e-02f, 9.12501454e-01f, 5.89144766e-01f, 1.97908238e-01f, 6.29583374e-02f, 1.99210308e-02f };
__device__ const float ROPE_COS_16[1024] = { 1.00000000e+00f, 1.00000000e+00f, 1.00000000e+00f, 1.00000000e+00f, 1.00000000e+00f, 1.00000000e+00f, 1.00000000e+00f, 1.00000000e+00f, 1.00000000e+00f, 1.00000000e+00f, 1.00000000e+00f, 1.00000000e+00f, 1.00000000e+00f, 1.00000000e+00f, 1.00000000e+00f, 1.00000000e+00f, 5.40302277e-01f, 8.46009135e-01f, 9.50415254e-01f, 9.84230220e-01f, 9.95004177e-01f, 9.98419285e-01f, 9.99500036e-01f, 9.99841869e-01f, 9.99949992e-01f, 9.99984205e-01f, 9.99994993e-01f, 9.99998391e-01f, 9.99999523e-01f, 9.99999821e-01f, 9.99999940e-01f, 1.00000000e+00f, -4.16146845e-01f, 4.31462824e-01f, 8.06578398e-01f, 9.37418282e-01f, 9.80066597e-01f, 9.93682086e-01f, 9.98000681e-01f, 9.99367595e-01f, 9.99800026e-01f, 9.99936759e-01f, 9.99979973e-01f, 9.99993682e-01f, 9.99997973e-01f, 9.99999344e-01f, 9.99999821e-01f, 9.99999940e-01f, -9.89992499e-01f, -1.15966164e-01f, 5.82753658e-01f, 8.61040652e-01f, 9.55336511e-01f, 9.85803485e-01f, 9.95503366e-01f, 9.98577297e-01f, 9.99550045e-01f, 9.99857724e-01f, 9.99954998e-01f, 9.99985754e-01f, 9.99995530e-01f, 9.99998569e-01f, 9.99999523e-01f, 9.99999881e-01f, -6.53643608e-01f, -6.27679706e-01f, 3.01137477e-01f, 7.57506192e-01f, 9.21060979e-01f, 9.74808276e-01f, 9.92010653e-01f, 9.97471273e-01f, 9.99200106e-01f, 9.99747038e-01f, 9.99920011e-01f, 9.99974728e-01f, 9.99992013e-01f, 9.99997497e-01f, 9.99999225e-01f, 9.99999762e-01f, 2.83662200e-01f, -9.46079254e-01f, -1.03423381e-02f, 6.30080283e-01f, 8.77582550e-01f, 9.60731268e-01f, 9.87526000e-01f, 9.96049762e-01f, 9.98750269e-01f, 9.99604762e-01f, 9.99875009e-01f, 9.99960482e-01f, 9.99987483e-01f, 9.99996066e-01f, 9.99998748e-01f, 9.99999583e-01f, 9.60170269e-01f, -9.73103702e-01f, -3.20796400e-01f, 4.82782036e-01f, 8.25335622e-01f, 9.43616986e-01f, 9.82053936e-01f, 9.94313300e-01f, 9.98200536e-01f, 9.99430835e-01f, 9.99819994e-01f, 9.99943078e-01f, 9.99981999e-01f, 9.99994338e-01f, 9.99998212e-01f, 9.99999404e-01f, 7.53902256e-01f, -7.00429797e-01f, -5.99437475e-01f, 3.20257008e-01f, 7.64842212e-01f, 9.23519433e-01f, 9.75599885e-01f, 9.92262423e-01f, 9.97551024e-01f, 9.99225318e-01f, 9.99755025e-01f, 9.99922514e-01f, 9.99975502e-01f, 9.99992251e-01f, 9.99997556e-01f, 9.99999225e-01f, -1.45500034e-01f, -2.12036446e-01f, -8.18632424e-01f, 1.47631213e-01f, 6.96706712e-01f, 9.00502324e-01f, 9.68170285e-01f, 9.89897788e-01f, 9.96801734e-01f, 9.98988271e-01f, 9.99680042e-01f, 9.99898791e-01f, 9.99967992e-01f, 9.99989867e-01f, 9.99996781e-01f, 9.99998987e-01f, -9.11130250e-01f, 3.41660261e-01f, -9.56644177e-01f, -2.96507962e-02f, 6.21609926e-01f, 8.74638259e-01f, 9.59772646e-01f, 9.87220109e-01f, 9.95952725e-01f, 9.98719573e-01f, 9.99595046e-01f, 9.99871910e-01f, 9.99959528e-01f, 9.99987185e-01f, 9.99995947e-01f, 9.99998748e-01f, -8.39071512e-01f, 7.90131867e-01f, -9.99786079e-01f, -2.05997631e-01f, 5.40302277e-01f, 8.46009135e-01f, 9.50415313e-01f, 9.84230220e-01f, 9.95004177e-01f, 9.98419285e-01f, 9.99500036e-01f, 9.99841869e-01f, 9.99949992e-01f, 9.99984205e-01f, 9.99994993e-01f, 9.99998391e-01f, 4.42569796e-03f, 9.95257378e-01f, -9.43779767e-01f, -3.75847399e-01f, 4.53596085e-01f, 8.14705312e-01f, 9.40107584e-01f, 9.80929136e-01f, 9.93956089e-01f, 9.98087406e-01f, 9.99395072e-01f, 9.99808669e-01f, 9.99939501e-01f, 9.99980867e-01f, 9.99993920e-01f, 9.99998093e-01f, 8.43853951e-01f, 8.93861592e-01f, -7.94179380e-01f, -5.33843040e-01f, 3.62357706e-01f, 7.80825913e-01f, 9.28859890e-01f, 9.77317870e-01f, 9.92808640e-01f, 9.97723997e-01f, 9.99280095e-01f, 9.99772310e-01f, 9.99927998e-01f, 9.99977231e-01f, 9.99992788e-01f, 9.99997735e-01f, 9.07446802e-01f, 5.17172873e-01f, -5.65820515e-01f, -6.75001681e-01f, 2.67498761e-01f, 7.44477987e-01f, 9.16683376e-01f, 9.73397553e-01f, 9.91561890e-01f, 9.97329056e-01f, 9.99155104e-01f, 9.99732792e-01f, 9.99915481e-01f, 9.99973297e-01f, 9.99991536e-01f, 9.99997318e-01f, 1.36737213e-01f, -1.87961515e-02f, -2.81349480e-01f, -7.94870913e-01f, 1.69967160e-01f, 7.05776393e-01f, 9.03590262e-01f, 9.69169438e-01f, 9.90216017e-01f, 9.96902585e-01f, 9.99020159e-01f, 9.99690115e-01f, 9.99902010e-01f, 9.99969006e-01f, 9.99990225e-01f, 9.99996901e-01f, -7.59687901e-01f, -5.48975468e-01f, 3.10223512e-02f, -8.89670432e-01f, 7.07371980e-02f, 6.64843500e-01f, 8.89593601e-01f, 9.64634836e-01f, 9.88771081e-01f, 9.96444523e-01f, 9.98875201e-01f, 9.99644279e-01f, 9.99887526e-01f, 9.99964416e-01f, 9.99988735e-01f, 9.99996424e-01f, -9.57659483e-01f, -9.10081089e-01f, 3.40318173e-01f, -9.56410050e-01f, -2.91995462e-02f, 6.21808827e-01f, 8.74707460e-01f, 9.59795177e-01f, 9.87227261e-01f, 9.95954990e-01f, 9.98720288e-01f, 9.99595284e-01f, 9.99872029e-01f, 9.99959528e-01f, 9.99987185e-01f, 9.99995947e-01f, -2.75163352e-01f, -9.90897954e-01f, 6.15864813e-01f, -9.92985010e-01f, -1.28844544e-01f, 5.76808274e-01f, 8.58946681e-01f, 9.54652011e-01f, 9.85584795e-01f, 9.95433986e-01f, 9.98555362e-01f, 9.99543071e-01f, 9.99855518e-01f, 9.99954283e-01f, 9.99985576e-01f, 9.99995410e-01f, 6.60316706e-01f, -7.66536534e-01f, 8.30336154e-01f, -9.98241663e-01f, -2.27202162e-01f, 5.29984176e-01f, 8.42327058e-01f, 9.49207008e-01f, 9.83843684e-01f, 9.94881511e-01f, 9.98380423e-01f, 9.99487758e-01f, 9.99837995e-01f, 9.99948800e-01f, 9.99983788e-01f, 9.99994874e-01f, 9.88704622e-01f, -3.06095392e-01f, 9.62463796e-01f, -9.72014248e-01f, -3.23289543e-01f, 4.81484592e-01f, 8.24865162e-01f, 9.43461835e-01f, 9.82004225e-01f, 9.94297504e-01f, 9.98195529e-01f, 9.99429286e-01f, 9.99819517e-01f, 9.99942899e-01f, 9.99981940e-01f, 9.99994278e-01f, 4.08082068e-01f, 2.48616725e-01f, 9.99144375e-01f, -9.15129960e-01f, -4.16146845e-01f, 4.31462824e-01f, 8.06578457e-01f, 9.37418282e-01f, 9.80066597e-01f, 9.93682086e-01f, 9.98000681e-01f, 9.99367595e-01f, 9.99800026e-01f, 9.99936759e-01f, 9.99979973e-01f, 9.99993682e-01f, -5.47729254e-01f, 7.26760268e-01f, 9.36740458e-01f, -8.29382956e-01f, -5.04846215e-01f, 3.80077004e-01f, 7.87485182e-01f, 9.31078374e-01f, 9.78030920e-01f, 9.93035257e-01f, 9.97795820e-01f, 9.99302804e-01f, 9.99779522e-01f, 9.99930263e-01f, 9.99977946e-01f, 9.99993026e-01f, -9.99960840e-01f, 9.81074572e-01f, 7.81440377e-01f, -7.17477441e-01f, -5.88501155e-01f, 3.27489585e-01f, 7.67604589e-01f, 9.24443960e-01f, 9.75897431e-01f, 9.92357016e-01f, 9.97581005e-01f, 9.99234855e-01f, 9.99758005e-01f, 9.99923468e-01f, 9.99975801e-01f, 9.99992371e-01f, -5.32833040e-01f, 9.33235765e-01f, 5.48645258e-01f, -5.82943261e-01f, -6.66275978e-01f, 2.73866832e-01f, 7.46956408e-01f, 9.17517304e-01f, 9.73666370e-01f, 9.91647422e-01f, 9.97356176e-01f, 9.99163687e-01f, 9.99735534e-01f, 9.99916375e-01f, 9.99973536e-01f, 9.99991655e-01f, 4.24179018e-01f, 5.97977161e-01f, 2.61441678e-01f, -4.30023283e-01f, -7.37393796e-01f, 2.19378278e-01f, 7.25561321e-01f, 9.10300434e-01f, 9.71337974e-01f, 9.90906477e-01f, 9.97121394e-01f, 9.99089420e-01f, 9.99711990e-01f, 9.99908924e-01f, 9.99971211e-01f, 9.99990880e-01f, 9.91202831e-01f, 7.85522610e-02f, -5.16893305e-02f, -2.63540596e-01f, -8.01143587e-01f, 1.64196163e-01f, 7.03440726e-01f, 9.02795732e-01f, 9.68912423e-01f, 9.90134120e-01f, 9.96876657e-01f, 9.99011934e-01f, 9.99687493e-01f, 9.99901175e-01f, 9.99968767e-01f, 9.99990106e-01f, 6.46919310e-01f, -4.65064496e-01f, -3.59694332e-01f, -8.87455046e-02f, -8.56888831e-01f, 1.08494945e-01f, 6.80616796e-01f, 8.95005584e-01f, 9.66389954e-01f, 9.89330530e-01f, 9.96621907e-01f, 9.98931348e-01f, 9.99662042e-01f, 9.99893129e-01f, 9.99966204e-01f, 9.99989331e-01f, -2.92138815e-01f, -8.65450621e-01f, -6.32028639e-01f, 8.88481140e-02f, -9.04072165e-01f, 5.24506159e-02f, 6.57112300e-01f, 8.86932373e-01f, 9.63770926e-01f, 9.88495648e-01f, 9.96357203e-01f, 9.98847544e-01f, 9.99635518e-01f, 9.99884725e-01f, 9.99963522e-01f, 9.99988496e-01f, -9.62605894e-01f, -9.99293387e-01f, -8.41684937e-01f, 2.63639510e-01f, -9.42222297e-01f, -3.75941908e-03f, 6.32950664e-01f, 8.78578722e-01f, 9.61055458e-01f, 9.87629473e-01f, 9.96082544e-01f, 9.98760641e-01f, 9.99608040e-01f, 9.99876022e-01f, 9.99960780e-01f, 9.99987602e-01f, -7.48057544e-01f, -8.25371623e-01f, -9.67871487e-01f, 4.30115849e-01f, -9.70958173e-01f, -5.99575676e-02f, 6.08156204e-01f, 8.69947195e-01f, 9.58243906e-01f, 9.86732066e-01f, 9.95797932e-01f, 9.98670578e-01f, 9.99579549e-01f, 9.99867022e-01f, 9.99957979e-01f, 9.99986708e-01f, 1.54251456e-01f, -3.97251874e-01f, -9.98075247e-01f, 5.83026946e-01f, -9.89992499e-01f, -1.15966164e-01f, 5.82753658e-01f, 8.61040652e-01f, 9.55336511e-01f, 9.85803485e-01f, 9.95503366e-01f, 9.98577297e-01f, 9.99550045e-01f, 9.99857724e-01f, 9.99954998e-01f, 9.99985754e-01f, 9.14742351e-01f, 1.53215483e-01f, -9.29300308e-01f, 7.17549205e-01f, -9.99135137e-01f, -1.71608135e-01f, 5.56768358e-01f, 8.51861775e-01f, 9.52333570e-01f, 9.84843671e-01f, 9.95198846e-01f, 9.98480916e-01f, 9.99519527e-01f, 9.99848068e-01f, 9.99951959e-01f, 9.99984801e-01f, 8.34223390e-01f, 6.56495154e-01f, -7.68367112e-01f, 8.29440355e-01f, -9.98294771e-01f, -2.26707578e-01f, 5.30226350e-01f, 8.42413545e-01f, 9.49235439e-01f, 9.83852804e-01f, 9.94884372e-01f, 9.98381376e-01f, 9.99488056e-01f, 9.99838114e-01f, 9.99948800e-01f, 9.99983788e-01f, -1.32767474e-02f, 9.57586050e-01f, -5.31235278e-01f, 9.15171385e-01f, -9.87479806e-01f, -2.81090319e-01f, 5.03154159e-01f, 8.32698941e-01f, 9.46042359e-01f, 9.82830763e-01f, 9.94559944e-01f, 9.98278618e-01f, 9.99455571e-01f, 9.99827802e-01f, 9.99945521e-01f, 9.99982774e-01f, -8.48570287e-01f, 9.63757515e-01f, -2.41421118e-01f, 9.72038329e-01f, -9.66798186e-01f, -3.34584385e-01f, 4.75578904e-01f, 8.22721004e-01f, 9.42754686e-01f, 9.81777668e-01f, 9.94225562e-01f, 9.98172760e-01f, 9.99422073e-01f, 9.99817252e-01f, 9.99942183e-01f, 9.99981701e-01f, -9.03692186e-01f, 6.73110247e-01f, 7.23346695e-02f, 9.98247743e-01f, -9.36456680e-01f, -3.87020677e-01f, 4.47528064e-01f, 8.12482953e-01f, 9.39372718e-01f, 9.80693519e-01f, 9.93881226e-01f, 9.98063743e-01f, 9.99387562e-01f, 9.99806345e-01f, 9.99938726e-01f, 9.99980628e-01f, -1.27963692e-01f, 1.75156534e-01f, 3.78916174e-01f, 9.92972851e-01f, -8.96758378e-01f, -4.38233554e-01f, 4.19029742e-01f, 8.01987886e-01f, 9.35896814e-01f, 9.79578316e-01f, 9.93526995e-01f, 9.97951567e-01f, 9.99352098e-01f, 9.99795079e-01f, 9.99935210e-01f, 9.99979496e-01f, 7.65414059e-01f, -3.76742303e-01f, 6.47921681e-01f, 9.56380010e-01f, -8.48100007e-01f, -4.88060862e-01f, 3.90112430e-01f, 7.91239262e-01f, 9.32327330e-01f, 9.78432178e-01f, 9.93162811e-01f, 9.97836173e-01f, 9.99315560e-01f, 9.99783576e-01f, 9.99931574e-01f, 9.99978364e-01f, 9.55073655e-01f, -8.12611222e-01f, 8.52673113e-01f, 8.89623463e-01f, -7.90967762e-01f, -5.36345184e-01f, 3.60805035e-01f, 7.80240417e-01f, 9.28664625e-01f, 9.77255106e-01f, 9.92788672e-01f, 9.97717679e-01f, 9.99278069e-01f, 9.99771714e-01f, 9.99927819e-01f, 9.99977171e-01f, 2.66642928e-01f, -9.98210371e-01f, 9.72865343e-01f, 7.94808388e-01f, -7.25932240e-01f, -5.82933903e-01f, 3.31136853e-01f, 7.68994927e-01f, 9.24909055e-01f, 9.76047099e-01f, 9.92404640e-01f, 9.97596025e-01f, 9.99239624e-01f, 9.99759495e-01f, 9.99923944e-01f, 9.99975979e-01f, -6.66938066e-01f, -8.76379430e-01f, 9.96578991e-01f, 6.74925625e-01f, -6.53643608e-01f, -6.27679706e-01f, 3.01137596e-01f, 7.57506192e-01f, 9.21060979e-01f, 9.74808276e-01f, 9.92010653e-01f, 9.97471273e-01f, 9.99200106e-01f, 9.99747038e-01f, 9.99920011e-01f, 9.99974728e-01f, -9.87339258e-01f, -4.84639406e-01f, 9.21462357e-01f, 5.33756077e-01f, -5.74824035e-01f, -6.70441091e-01f, 2.70837069e-01f, 7.45777905e-01f, 9.17120814e-01f, 9.73538578e-01f, 9.91606772e-01f, 9.97343302e-01f, 9.99159634e-01f, 9.99734223e-01f, 9.99915957e-01f, 9.99973416e-01f, -3.99985313e-01f, 5.63609414e-02f, 7.54965365e-01f, 3.75752151e-01f, -4.90260571e-01f, -7.11082935e-01f, 2.40265876e-01f, 7.33813822e-01f, 9.13088918e-01f, 9.72238123e-01f, 9.91192937e-01f, 9.97212172e-01f, 9.99118149e-01f, 9.99721110e-01f, 9.99911785e-01f, 9.99972105e-01f, 5.55113316e-01f, 5.80003142e-01f, 5.13598442e-01f, 2.05897167e-01f, -4.00799006e-01f, -7.49476731e-01f, 2.09454417e-01f, 7.21617639e-01f, 9.08965766e-01f, 9.70906913e-01f, 9.90769207e-01f, 9.97077882e-01f, 9.99075651e-01f, 9.99707639e-01f, 9.99907553e-01f, 9.99970794e-01f, 9.99843299e-01f, 9.25014675e-01f, 2.21298173e-01f, 2.95478199e-02f, -3.07332784e-01f, -7.85501122e-01f, 1.78433523e-01f, 7.09193349e-01f, 9.04751658e-01f, 9.69545007e-01f, 9.90335584e-01f, 9.96940494e-01f, 9.99032140e-01f, 9.99693930e-01f, 9.99903202e-01f, 9.99969363e-01f, 5.25321960e-01f, 9.85138178e-01f, -9.29481089e-02f, -1.47732988e-01f, -2.10795805e-01f, -8.19042206e-01f, 1.47234216e-01f, 6.96544766e-01f, 9.00447130e-01f, 9.68152404e-01f, 9.89892066e-01f, 9.96799886e-01f, 9.98987675e-01f, 9.99679863e-01f, 9.99898732e-01f, 9.99967992e-01f, -4.32177931e-01f, 7.41858006e-01f, -3.97976756e-01f, -3.20354372e-01f, -1.12152621e-01f, -8.49993885e-01f, 1.15887694e-01f, 6.83675885e-01f, 8.96052480e-01f, 9.66729224e-01f, 9.89438653e-01f, 9.96656179e-01f, 9.98942196e-01f, 9.99665439e-01f, 9.99894202e-01f, 9.99966562e-01f, -9.92335498e-01f, 2.70098448e-01f, -6.63538277e-01f, -4.82871950e-01f, -1.23883775e-02f, -8.78258407e-01f, 8.44252855e-02f, 6.70590878e-01f, 8.91568303e-01f, 9.65275466e-01f, 9.88975346e-01f, 9.96509314e-01f, 9.98895705e-01f, 9.99650776e-01f, 9.99889553e-01f, 9.99965072e-01f, -6.40144348e-01f, -2.84846604e-01f, -8.63296509e-01f, -6.30159974e-01f, 8.74991715e-02f, -9.03746367e-01f, 5.28784581e-02f, 6.57293737e-01f, 8.86994898e-01f, 9.63791192e-01f, 9.88502085e-01f, 9.96359289e-01f, 9.98848200e-01f, 9.99635756e-01f, 9.99884784e-01f, 9.99963582e-01f, 3.00592542e-01f, -7.52063990e-01f, -9.77442741e-01f, -7.57573068e-01f, 1.86512470e-01f, -9.26377118e-01f, 2.12787576e-02f, 6.43788815e-01f, 8.82332861e-01f, 9.62276459e-01f, 9.88018990e-01f, 9.96206105e-01f, 9.98799741e-01f, 9.99620378e-01f, 9.99879956e-01f, 9.99962032e-01f, 9.64965999e-01f, -9.87659097e-01f, -9.94656444e-01f, -8.61092687e-01f, 2.83662200e-01f, -9.46079254e-01f, -1.03422189e-02f, 6.30080283e-01f, 8.77582550e-01f, 9.60731268e-01f, 9.87526000e-01f, 9.96049762e-01f, 9.98750269e-01f, 9.99604762e-01f, 9.99875009e-01f, 9.99960482e-01f, 7.42154181e-01f, -9.19073522e-01f, -9.13230121e-01f, -9.37454224e-01f, 3.77977669e-01f, -9.62790370e-01f, -4.19528559e-02f, 6.16172493e-01f, 8.72744501e-01f, 9.59155679e-01f, 9.87023175e-01f, 9.95890260e-01f, 9.98699784e-01f, 9.99588788e-01f, 9.99869943e-01f, 9.99958873e-01f, -1.62990779e-01f, -5.67430019e-01f, -7.41239965e-01f, -9.84248459e-01f, 4.68516916e-01f, -9.76457715e-01f, -7.35215396e-02f, 6.02069914e-01f, 8.67819190e-01f, 9.57549810e-01f, 9.86510456e-01f, 9.95727658e-01f, 9.98648286e-01f, 9.99572515e-01f, 9.99864817e-01f, 9.99957263e-01f, -9.18282807e-01f, -4.10281904e-02f, -4.95741814e-01f, -1.00000000e+00f, 5.54374516e-01f, -9.87038016e-01f, -1.05016708e-01f, 5.87776959e-01f, 8.62807095e-01f, 9.55913603e-01f, 9.85987842e-01f, 9.95561838e-01f, 9.98595834e-01f, 9.99555886e-01f, 9.99859571e-01f, 9.99955595e-01f, -8.29309821e-01f, 4.98009592e-01f, -2.01079622e-01f, -9.84212041e-01f, 6.34692967e-01f, -9.94497895e-01f, -1.36406869e-01f, 5.73298037e-01f, 8.57708693e-01f, 9.54247177e-01f, 9.85455394e-01f, 9.95392919e-01f, 9.98542368e-01f, 9.99538958e-01f, 9.99854207e-01f, 9.99953866e-01f, 2.21267566e-02f, 8.83669317e-01f, 1.13521777e-01f, -9.37382519e-01f, 7.08669782e-01f, -9.98813629e-01f, -1.67660639e-01f, 5.58637917e-01f, 8.52524519e-01f, 9.52550590e-01f, 9.84913111e-01f, 9.95220840e-01f, 9.98487890e-01f, 9.99521732e-01f, 9.99848783e-01f, 9.99952197e-01f, 8.53220105e-01f, 9.97174621e-01f, 4.16867077e-01f, -8.60988438e-01f, 7.75565803e-01f, -9.99971747e-01f, -1.98746875e-01f, 5.43801069e-01f, 8.47255111e-01f, 9.50823903e-01f, 9.84360933e-01f, 9.95045662e-01f, 9.98432398e-01f, 9.99504209e-01f, 9.99843180e-01f, 9.99950409e-01f, 8.99866819e-01f, 8.03569078e-01f, 6.78870201e-01f, -7.57439196e-01f, 8.34712923e-01f, -9.97968495e-01f, -2.29634270e-01f, 5.28792322e-01f, 8.41901004e-01f, 9.49067116e-01f, 9.83798921e-01f, 9.94867265e-01f, 9.98375952e-01f, 9.99486327e-01f, 9.99837577e-01f, 9.99948621e-01f, 1.19180135e-01f, 3.62476677e-01f, 8.73550534e-01f, -6.30000710e-01f, 8.85519624e-01f, -9.92810190e-01f, -2.60292053e-01f, 5.13616323e-01f, 8.36462677e-01f, 9.47280347e-01f, 9.83227074e-01f, 9.94685769e-01f, 9.98318493e-01f, 9.99468148e-01f, 9.99831796e-01f, 9.99946833e-01f, -7.71080196e-01f, -1.90249100e-01f, 9.81602073e-01f, -4.82692331e-01f, 9.27478492e-01f, -9.84513164e-01f, -2.90689558e-01f, 4.98277903e-01f, 8.30940723e-01f, 9.45463598e-01f, 9.82645452e-01f, 9.94501114e-01f, 9.98260021e-01f, 9.99449670e-01f, 9.99825954e-01f, 9.99944985e-01f, -9.52412963e-01f, -6.84381902e-01f, 9.92308319e-01f, -3.20159167e-01f, 9.60170269e-01f, -9.73103702e-01f, -3.20796400e-01f, 4.82782036e-01f, 8.25335622e-01f, 9.43616986e-01f, 9.82053936e-01f, 9.94313300e-01f, 9.98200536e-01f, 9.99430835e-01f, 9.99819994e-01f, 9.99943078e-01f, -2.58101642e-01f, -9.67739642e-01f, 9.04607594e-01f, -1.47529200e-01f, 9.83268440e-01f, -9.58617806e-01f, -3.50582451e-01f, 4.67133403e-01f, 8.19648027e-01f, 9.41740453e-01f, 9.81452644e-01f, 9.94122326e-01f, 9.98140097e-01f, 9.99411702e-01f, 9.99813974e-01f, 9.99941170e-01f, 6.73507154e-01f, -9.53050017e-01f, 7.27198064e-01f, 2.97537707e-02f, 9.96542096e-01f, -9.41101313e-01f, -3.80017966e-01f, 4.51337039e-01f, 8.13878477e-01f, 9.39834237e-01f, 9.80841517e-01f, 9.93928254e-01f, 9.98078644e-01f, 9.99392271e-01f, 9.99807835e-01f, 9.99939203e-01f, 9.85896587e-01f, -6.44837022e-01f, 4.77671444e-01f, 2.06098333e-01f, 9.99858618e-01f, -9.20609534e-01f, -4.09073502e-01f, 4.35397953e-01f, 8.08027506e-01f, 9.37898219e-01f, 9.80220556e-01f, 9.93731022e-01f, 9.98016179e-01f, 9.99372482e-01f, 9.99801576e-01f, 9.99937236e-01f };
__device__ const float ROPE_SIN_16[1024] = { 0.00000000e+00f, 0.00000000e+00f, 0.00000000e+00f, 0.00000000e+00f, 0.00000000e+00f, 0.00000000e+00f, 0.00000000e+00f, 0.00000000e+00f, 0.00000000e+00f, 0.00000000e+00f, 0.00000000e+00f, 0.00000000e+00f, 0.00000000e+00f, 0.00000000e+00f, 0.00000000e+00f, 0.00000000e+00f, 8.41470957e-01f, 5.33168435e-01f, 3.10983598e-01f, 1.76892191e-01f, 9.98334214e-02f, 5.62044978e-02f, 3.16175036e-02f, 1.77818574e-02f, 9.99983307e-03f, 5.62338345e-03f, 3.16227227e-03f, 1.77827850e-03f, 9.99999931e-04f, 5.62341243e-04f, 3.16227757e-04f, 1.77827940e-04f, 9.09297407e-01f, 9.02130723e-01f, 5.91127098e-01f, 3.48205268e-01f, 1.98669329e-01f, 1.12231314e-01f, 6.32033944e-02f, 3.55580896e-02f, 1.99986659e-02f, 1.12465890e-02f, 6.32451288e-03f, 3.55655141e-03f, 1.99999870e-03f, 1.12468237e-03f, 6.32455456e-04f, 3.55655880e-04f, 1.41120002e-01f, 9.93253171e-01f, 8.12648892e-01f, 5.08536100e-01f, 2.95520216e-01f, 1.67903304e-01f, 9.47260857e-02f, 5.33230826e-02f, 2.99954992e-02f, 1.68694388e-02f, 9.48669016e-03f, 5.33481315e-03f, 2.99999560e-03f, 1.68702309e-03f, 9.48683126e-04f, 5.33483806e-04f, -7.56802499e-01f, 7.78471708e-01f, 9.53580737e-01f, 6.52827978e-01f, 3.89418334e-01f, 2.23044485e-01f, 1.26154065e-01f, 7.10712075e-02f, 3.99893336e-02f, 2.24917568e-02f, 1.26487734e-02f, 7.11305765e-03f, 3.99998948e-03f, 2.24936334e-03f, 1.26491068e-03f, 7.11311703e-04f, -9.58924294e-01f, 3.23935270e-01f, 9.99946535e-01f, 7.76529968e-01f, 4.79425550e-01f, 2.77480543e-01f, 1.57455876e-01f, 8.87968615e-02f, 4.99791652e-02f, 2.81133614e-02f, 1.58107281e-02f, 8.89127981e-03f, 4.99997940e-03f, 2.81170290e-03f, 1.58113812e-03f, 8.89139599e-04f, -2.79415488e-01f, -2.30367512e-01f, 9.47148204e-01f, 8.75740528e-01f, 5.64642489e-01f, 3.31039310e-01f, 1.88600272e-01f, 1.06494442e-01f, 5.99640049e-02f, 3.37340795e-02f, 1.89725272e-02f, 1.06694745e-02f, 5.99996420e-03f, 3.37404152e-03f, 1.89736532e-03f, 1.06696738e-03f, 6.56986594e-01f, -7.13721275e-01f, 8.00421596e-01f, 9.47330713e-01f, 6.44217670e-01f, 3.83551568e-01f, 2.19556093e-01f, 1.24158338e-01f, 6.99428469e-02f, 3.93537246e-02f, 2.21341345e-02f, 1.24476347e-02f, 6.99994294e-03f, 3.93637875e-03f, 2.21359241e-03f, 1.24479528e-03f, 9.89358246e-01f, -9.77261782e-01f, 5.74317753e-01f, 9.89042461e-01f, 7.17356086e-01f, 4.34851229e-01f, 2.50292331e-01f, 1.41782969e-01f, 7.99146891e-02f, 4.49721329e-02f, 2.52955221e-02f, 1.42257558e-02f, 7.99991470e-03f, 4.49871505e-03f, 2.52981926e-03f, 1.42262306e-03f, 4.12118495e-01f, -9.39823508e-01f, 2.91259229e-01f, 9.99560297e-01f, 7.83326924e-01f, 4.84776139e-01f, 2.80778319e-01f, 1.59362778e-01f, 8.98785442e-02f, 5.05891182e-02f, 2.84566563e-02f, 1.60038304e-02f, 8.99987947e-03f, 5.06105041e-03f, 2.84604589e-03f, 1.60045072e-03f, -5.44021130e-01f, -6.12936914e-01f, -2.06835698e-02f, 9.78552461e-01f, 8.41470957e-01f, 5.33168435e-01f, 3.10983568e-01f, 1.76892191e-01f, 9.98334140e-02f, 5.62044978e-02f, 3.16175036e-02f, 1.77818574e-02f, 9.99983400e-03f, 5.62338345e-03f, 3.16227227e-03f, 1.77827850e-03f, -9.99990225e-01f, -9.72764567e-02f, -3.30574960e-01f, 9.26681578e-01f, 8.91207397e-01f, 5.79875171e-01f, 3.40877861e-01f, 1.94365650e-01f, 1.09778300e-01f, 6.18181042e-02f, 3.47780399e-02f, 1.95598267e-02f, 1.09997792e-02f, 6.18571462e-03f, 3.47849843e-03f, 1.95610616e-03f, -5.36572933e-01f, 4.48342979e-01f, -6.07683420e-01f, 8.45583618e-01f, 9.32039082e-01f, 6.24748647e-01f, 3.70431304e-01f, 2.11777672e-01f, 1.19712204e-01f, 6.74297586e-02f, 3.79382223e-02f, 2.13377345e-02f, 1.19997123e-02f, 6.74804440e-03f, 3.79472389e-03f, 2.13393359e-03f, 4.20167029e-01f, 8.55880976e-01f, -8.24528456e-01f, 7.37816215e-01f, 9.63558197e-01f, 6.67647004e-01f, 3.99614304e-01f, 2.29122713e-01f, 1.29634142e-01f, 7.30392784e-02f, 4.10980321e-02f, 2.31155735e-02f, 1.29996343e-02f, 7.31037185e-03f, 4.11094911e-03f, 2.31176103e-03f, 9.90607381e-01f, 9.99823332e-01f, -9.59605396e-01f, 6.06778562e-01f, 9.85449731e-01f, 7.08434701e-01f, 4.28397775e-01f, 2.46395305e-01f, 1.39543116e-01f, 7.86464810e-02f, 4.42574248e-02f, 2.48933397e-02f, 1.39995432e-02f, 7.87269697e-03f, 4.42717411e-03f, 2.48958869e-03f, 6.50287867e-01f, 8.35838437e-01f, -9.99518692e-01f, 4.56603259e-01f, 9.97494996e-01f, 7.46982634e-01f, 4.56752867e-01f, 2.63589978e-01f, 1.49438128e-01f, 8.42512026e-02f, 4.74163815e-02f, 2.66710296e-02f, 1.49994381e-02f, 8.43502022e-03f, 4.74339863e-03f, 2.66741589e-03f, -2.87903309e-01f, 4.14430231e-01f, -9.40310359e-01f, 2.92027086e-01f, 9.99573588e-01f, 7.83169091e-01f, 4.84651238e-01f, 2.80701309e-01f, 1.59318209e-01f, 8.98532644e-02f, 5.05748577e-02f, 2.84486320e-02f, 1.59993190e-02f, 8.99733976e-03f, 5.05962269e-03f, 2.84524332e-03f, -9.61397469e-01f, -1.34615138e-01f, -7.87851870e-01f, 1.18240520e-01f, 9.91664827e-01f, 8.16879570e-01f, 5.12064993e-01f, 2.97723860e-01f, 1.69182345e-01f, 9.54524800e-02f, 5.37328273e-02f, 3.02261449e-02f, 1.69991814e-02f, 9.55965649e-03f, 5.37584582e-03f, 3.02307028e-03f, -7.50987232e-01f, -6.42200708e-01f, -5.57262897e-01f, -5.92755191e-02f, 9.73847628e-01f, 8.48007560e-01f, 5.38966715e-01f, 3.14652264e-01f, 1.79029569e-01f, 1.01048686e-01f, 5.68902642e-02f, 3.20035629e-02f, 1.79990288e-02f, 1.01219704e-02f, 5.69206895e-03f, 3.20089748e-03f, 1.49877205e-01f, -9.52000856e-01f, -2.71410108e-01f, -2.34921798e-01f, 9.46300089e-01f, 8.76454532e-01f, 5.65329552e-01f, 3.31481189e-01f, 1.88858896e-01f, 1.06641680e-01f, 6.00471310e-02f, 3.37808803e-02f, 1.89988576e-02f, 1.06842816e-02f, 6.00829115e-03f, 3.37872445e-03f, 9.12945271e-01f, -9.68601942e-01f, 4.13582884e-02f, -4.03158993e-01f, 9.09297407e-01f, 9.02130723e-01f, 5.91127038e-01f, 3.48205268e-01f, 1.98669314e-01f, 1.12231314e-01f, 6.32033944e-02f, 3.55580896e-02f, 1.99986678e-02f, 1.12465890e-02f, 6.32451288e-03f, 3.55655141e-03f, 8.36655617e-01f, -6.86891198e-01f, 3.50024760e-01f, -5.58680534e-01f, 8.63209307e-01f, 9.24954832e-01f, 6.16333544e-01f, 3.64819258e-01f, 2.08459899e-01f, 1.17817394e-01f, 6.63590282e-02f, 3.73351872e-02f, 2.09984574e-02f, 1.18088927e-02f, 6.64073415e-03f, 3.73437814e-03f, -8.85130931e-03f, -1.93630233e-01f, 6.23979926e-01f, -6.96581721e-01f, 8.08496356e-01f, 9.44854796e-01f, 6.40923738e-01f, 3.81317884e-01f, 2.18229622e-01f, 1.23399742e-01f, 6.95140064e-02f, 3.91121693e-02f, 2.19982266e-02f, 1.23711927e-02f, 6.95695449e-03f, 3.91220488e-03f, -8.46220434e-01f, 3.59264523e-01f, 8.36055279e-01f, -8.12512875e-01f, 7.45705247e-01f, 9.61767614e-01f, 6.64873064e-01f, 3.97695929e-01f, 2.27977514e-01f, 1.28978193e-01f, 7.26682767e-02f, 4.08890247e-02f, 2.29979735e-02f, 1.29334899e-02f, 7.27317436e-03f, 4.09003161e-03f, -9.05578375e-01f, 8.01513135e-01f, 9.65219259e-01f, -9.02817786e-01f, 6.75463140e-01f, 9.75639880e-01f, 6.88157499e-01f, 4.13948208e-01f, 2.37702623e-01f, 1.34552568e-01f, 7.58218244e-02f, 4.26657498e-02f, 2.39976961e-02f, 1.34957815e-02f, 7.58939330e-03f, 4.26785741e-03f, -1.32351756e-01f, 9.96909976e-01f, 9.98663187e-01f, -9.64648306e-01f, 5.98472118e-01f, 9.86427724e-01f, 7.10753918e-01f, 4.30069596e-01f, 2.47403964e-01f, 1.40122697e-01f, 7.89746121e-02f, 4.44423407e-02f, 2.49973964e-02f, 1.40580693e-02f, 7.90561177e-03f, 4.44568414e-03f, 7.62558460e-01f, 8.85276794e-01f, 9.33070183e-01f, -9.96054351e-01f, 5.15501261e-01f, 9.94096994e-01f, 7.32639611e-01f, 4.46054995e-01f, 2.57080555e-01f, 1.45688385e-01f, 8.21266174e-02f, 4.62187938e-02f, 2.59970706e-02f, 1.46203535e-02f, 8.22182931e-03f, 4.62350994e-03f, 9.56375957e-01f, 5.00994205e-01f, 7.74945021e-01f, -9.96045172e-01f, 4.27379847e-01f, 9.98623490e-01f, 7.53792703e-01f, 4.61899310e-01f, 2.66731411e-01f, 1.51249468e-01f, 8.52777958e-02f, 4.79951017e-02f, 2.69967206e-02f, 1.51826320e-02f, 8.53804592e-03f, 4.80133574e-03f, 2.70905793e-01f, -3.75856608e-02f, 5.39968967e-01f, -9.64621305e-01f, 3.34988207e-01f, 9.99992907e-01f, 7.74192095e-01f, 4.77597594e-01f, 2.76355654e-01f, 1.56805754e-01f, 8.84281173e-02f, 4.97712530e-02f, 2.79963426e-02f, 1.57449059e-02f, 8.85426160e-03f, 4.97916201e-03f, -6.63633883e-01f, -5.64589798e-01f, 2.51445323e-01f, -9.02773678e-01f, 2.39249229e-01f, 9.98200953e-01f, 7.93817401e-01f, 4.93144840e-01f, 2.85952210e-01f, 1.62357092e-01f, 9.15775672e-02f, 5.15472479e-02f, 2.89959367e-02f, 1.63071752e-02f, 9.17047635e-03f, 5.15698735e-03f, -9.88031626e-01f, -9.17709649e-01f, -6.20148405e-02f, -8.12452853e-01f, 1.41120002e-01f, 9.93253171e-01f, 8.12648892e-01f, 5.08536100e-01f, 2.95520186e-01f, 1.67903304e-01f, 9.47260931e-02f, 5.33230826e-02f, 2.99955010e-02f, 1.68694388e-02f, 9.48669016e-03f, 5.33481315e-03f, -4.04037654e-01f, -9.88192797e-01f, -3.69325012e-01f, -6.96507812e-01f, 4.15805206e-02f, 9.85165298e-01f, 8.30667794e-01f, 5.23766637e-01f, 3.05058628e-01f, 1.73444211e-01f, 9.78736654e-02f, 5.50987460e-02f, 3.09950355e-02f, 1.74316969e-02f, 9.80290305e-03f, 5.51263802e-03f, 5.51426709e-01f, -7.54330218e-01f, -6.40009403e-01f, -5.58595300e-01f, -5.83741926e-02f, 9.73962843e-01f, 8.47856104e-01f, 5.38831532e-01f, 3.14566553e-01f, 1.78979620e-01f, 1.01020269e-01f, 5.68742342e-02f, 3.19945402e-02f, 1.79939512e-02f, 1.01191159e-02f, 5.69046335e-03f, 9.99911845e-01f, -2.88147390e-01f, -8.47224355e-01f, -4.03064936e-01f, -1.57745644e-01f, 9.59681332e-01f, 8.64196658e-01f, 5.53726017e-01f, 3.24043006e-01f, 1.84509367e-01f, 1.04165860e-01f, 5.86495437e-02f, 3.29940096e-02f, 1.85561981e-02f, 1.04353270e-02f, 5.86828869e-03f, 5.29082716e-01f, 2.66779721e-01f, -9.70420420e-01f, -2.34822124e-01f, -2.55541205e-01f, 9.42365825e-01f, 8.79673064e-01f, 5.68445385e-01f, 3.33487093e-01f, 1.90033287e-01f, 1.07310407e-01f, 6.04246669e-02f, 3.39934528e-02f, 1.91184394e-02f, 1.07515370e-02f, 6.04611309e-03f, -4.28182662e-01f, 7.39542127e-01f, -9.97380435e-01f, -5.91726787e-02f, -3.50783229e-01f, 9.22071040e-01f, 8.94269884e-01f, 5.82984984e-01f, 3.42897803e-01f, 1.95551202e-01f, 1.10453881e-01f, 6.21996038e-02f, 3.49928550e-02f, 1.96806751e-02f, 1.10677453e-02f, 6.22393796e-03f, -9.91778851e-01f, 9.84540582e-01f, -9.25431013e-01f, 1.18342586e-01f, -4.42520559e-01f, 8.98861170e-01f, 9.07972515e-01f, 5.97340286e-01f, 3.52274209e-01f, 2.01062918e-01f, 1.13596253e-01f, 6.39743358e-02f, 3.59922275e-02f, 2.02429052e-02f, 1.13839535e-02f, 6.40176190e-03f, -6.43538117e-01f, 9.26318109e-01f, -7.61706948e-01f, 2.92125374e-01f, -5.29836178e-01f, 8.72809589e-01f, 9.20767248e-01f, 6.11506701e-01f, 3.61615449e-01f, 2.06568271e-01f, 1.16737492e-01f, 6.57488778e-02f, 3.69915590e-02f, 2.08051261e-02f, 1.17001599e-02f, 6.57958630e-03f, 2.96368569e-01f, 5.82806170e-01f, -5.22444785e-01f, 4.56694692e-01f, -6.11857831e-01f, 8.43998730e-01f, 9.32641268e-01f, 6.25479698e-01f, 3.70920479e-01f, 2.12067112e-01f, 1.19877554e-01f, 6.75232038e-02f, 3.79908569e-02f, 2.13673431e-02f, 1.20163653e-02f, 6.75741071e-03f, 9.63795364e-01f, 5.98003156e-02f, -2.31372014e-01f, 6.06860459e-01f, -6.87766254e-01f, 8.12519610e-01f, 9.43582714e-01f, 6.39254928e-01f, 3.80188406e-01f, 2.17559248e-01f, 1.23016424e-01f, 6.92973137e-02f, 3.89901139e-02f, 2.19295528e-02f, 1.23325698e-02f, 6.93523418e-03f, 7.45113134e-01f, -4.81621295e-01f, 8.26458037e-02f, 7.37885714e-01f, -7.56802499e-01f, 7.78471708e-01f, 9.53580678e-01f, 6.52827978e-01f, 3.89418334e-01f, 2.23044485e-01f, 1.26154065e-01f, 7.10712075e-02f, 3.99893373e-02f, 2.24917568e-02f, 1.26487734e-02f, 7.11305765e-03f, -1.58622667e-01f, -8.74714017e-01f, 3.88467699e-01f, 8.45638454e-01f, -8.18277061e-01f, 7.41962790e-01f, 9.62625206e-01f, 6.66194677e-01f, 3.98609310e-01f, 2.28522688e-01f, 1.29290432e-01f, 7.28448778e-02f, 4.09885161e-02f, 2.30539497e-02f, 1.29649751e-02f, 7.29088066e-03f, -9.16521549e-01f, -9.98410463e-01f, 6.55764699e-01f, 9.26720202e-01f, -8.71575892e-01f, 7.03108132e-01f, 9.70707119e-01f, 6.79350674e-01f, 4.07760441e-01f, 2.33993664e-01f, 1.32425532e-01f, 7.46183172e-02f, 4.19876575e-02f, 2.36161388e-02f, 1.32811759e-02f, 7.46870413e-03f, -8.31774771e-01f, -8.14614236e-01f, 8.58030677e-01f, 9.78573620e-01f, -9.16166008e-01f, 6.62030637e-01f, 9.77818429e-01f, 6.92291796e-01f, 4.16870773e-01f, 2.39457220e-01f, 1.35559291e-01f, 7.63915181e-02f, 4.29867506e-02f, 2.41783205e-02f, 1.35973748e-02f, 7.64652714e-03f, 1.77019257e-02f, -3.79931390e-01f, 9.75206196e-01f, 9.99563396e-01f, -9.51602101e-01f, 6.18860185e-01f, 9.83951986e-01f, 7.05014050e-01f, 4.25939471e-01f, 2.44913206e-01f, 1.38691694e-01f, 7.81644881e-02f, 4.39858064e-02f, 2.47404929e-02f, 1.39135728e-02f, 7.82434922e-03f, 8.50903511e-01f, 1.71763569e-01f, 9.95670974e-01f, 9.89027262e-01f, -9.77530122e-01f, 5.73733270e-01f, 9.89101648e-01f, 7.17513323e-01f, 4.34965521e-01f, 2.50361472e-01f, 1.41822711e-01f, 7.99371973e-02f, 4.49848175e-02f, 2.53026579e-02f, 1.42297689e-02f, 8.00217129e-03f, 9.01788354e-01f, 6.70557022e-01f, 9.17395473e-01f, 9.47297752e-01f, -9.93690968e-01f, 5.26792526e-01f, 9.93262351e-01f, 7.29785740e-01f, 4.43948090e-01f, 2.55801797e-01f, 1.44952312e-01f, 8.17096606e-02f, 4.59837839e-02f, 2.58648153e-02f, 1.45459641e-02f, 8.17999430e-03f, 1.23573124e-01f, 9.62832689e-01f, 7.48142362e-01f, 8.75690997e-01f, -9.99923289e-01f, 4.78186339e-01f, 9.96429801e-01f, 7.41827428e-01f, 4.52886283e-01f, 2.61234075e-01f, 1.48080453e-01f, 8.34818557e-02f, 4.69827019e-02f, 2.64269635e-02f, 1.48621574e-02f, 8.35781638e-03f, -7.68254638e-01f, 9.58573103e-01f, 5.04697084e-01f, 7.76465356e-01f, -9.96164620e-01f, 4.28068399e-01f, 9.98600960e-01f, 7.53634512e-01f, 4.61779177e-01f, 2.66658038e-01f, 1.51207119e-01f, 8.52537975e-02f, 4.79815714e-02f, 2.69891042e-02f, 1.51783489e-02f, 8.53563752e-03f, -9.53752637e-01f, 6.59090102e-01f, 2.11200655e-01f, 6.52750373e-01f, -9.82452571e-01f, 3.76597136e-01f, 9.99773562e-01f, 7.65203178e-01f, 4.70625877e-01f, 2.72073567e-01f, 1.54332280e-01f, 8.70254710e-02f, 4.89803962e-02f, 2.75512375e-02f, 1.54945394e-02f, 8.71345960e-03f, -2.62374848e-01f, 1.56619072e-01f, -1.03240460e-01f, 5.08447945e-01f, -9.58924294e-01f, 3.23935270e-01f, 9.99946535e-01f, 7.76529968e-01f, 4.79425550e-01f, 2.77480543e-01f, 1.57455891e-01f, 8.87968615e-02f, 4.99791689e-02f, 2.81133596e-02f, 1.58107281e-02f, 8.89127981e-03f, 6.70229197e-01f, -3.94086063e-01f, -4.07444149e-01f, 3.48108500e-01f, -9.25814748e-01f, 2.70249337e-01f, 9.99119580e-01f, 7.87611187e-01f, 4.88177240e-01f, 2.82878697e-01f, 1.60577938e-01f, 9.05679762e-02f, 5.09778969e-02f, 2.86754742e-02f, 1.61269177e-02f, 9.06910095e-03f, 9.86627579e-01f, -8.23421597e-01f, -6.71240151e-01f, 1.76790684e-01f, -8.83454502e-01f, 2.15709001e-01f, 9.97293651e-01f, 7.98443377e-01f, 4.96880114e-01f, 2.88267940e-01f, 1.63698375e-01f, 9.23388004e-02f, 5.19765690e-02f, 2.92375814e-02f, 1.64431017e-02f, 9.24692024e-03f, 3.95925164e-01f, -9.99157965e-01f, -8.68469954e-01f, -1.03020677e-04f, -8.32267344e-01f, 1.60486728e-01f, 9.94470477e-01f, 8.09023023e-01f, 5.05533338e-01f, 2.93648034e-01f, 1.66817173e-01f, 9.41093415e-02f, 5.29751927e-02f, 2.97996756e-02f, 1.67592876e-02f, 9.42474138e-03f, -5.58789074e-01f, -8.67171526e-01f, -9.79574919e-01f, -1.76993474e-01f, -7.72764444e-01f, 1.04756832e-01f, 9.90652919e-01f, 8.19346905e-01f, 5.14135957e-01f, 2.99018890e-01f, 1.69934288e-01f, 9.58795771e-02f, 5.39737605e-02f, 3.03617641e-02f, 1.70754679e-02f, 9.60256159e-03f, -9.99755144e-01f, -4.68111664e-01f, -9.93535519e-01f, -3.48301649e-01f, -7.05540299e-01f, 4.86960001e-02f, 9.85844791e-01f, 8.29411685e-01f, 5.22687256e-01f, 3.04380238e-01f, 1.73049718e-01f, 9.76495072e-02f, 5.49722798e-02f, 3.09238415e-02f, 1.73916500e-02f, 9.78038087e-03f, -5.21551013e-01f, 7.51182064e-02f, -9.08967435e-01f, -5.08624554e-01f, -6.31266713e-01f, -7.51878507e-03f, 9.80050862e-01f, 8.39214146e-01f, 5.31186223e-01f, 3.09731960e-01f, 1.76163420e-01f, 9.94191393e-02f, 5.59707358e-02f, 3.14859077e-02f, 1.77078284e-02f, 9.95820016e-03f, 4.36164767e-01f, 5.95211506e-01f, -7.34258294e-01f, -6.52905703e-01f, -5.50685287e-01f, -6.37097955e-02f, 9.73276973e-01f, 8.48751247e-01f, 5.39632022e-01f, 3.15073937e-01f, 1.79275364e-01f, 1.01188451e-01f, 5.69691435e-02f, 3.20479684e-02f, 1.80240069e-02f, 1.01360194e-02f, 9.92872655e-01f, 9.31992829e-01f, -4.86733496e-01f, -7.76594579e-01f, -4.64602023e-01f, -1.19699396e-01f, 9.65529919e-01f, 8.58020008e-01f, 5.48023939e-01f, 3.20405900e-01f, 1.82385504e-01f, 1.02957435e-01f, 5.79674877e-02f, 3.26100141e-02f, 1.83401816e-02f, 1.03138378e-02f, 6.36738002e-01f, 9.81735826e-01f, -1.90938011e-01f, -8.75790000e-01f, -3.73876572e-01f, -1.75310582e-01f, 9.56817448e-01f, 8.67017388e-01f, 5.56361020e-01f, 3.25727791e-01f, 1.85493827e-01f, 1.04726106e-01f, 5.89657798e-02f, 3.31720486e-02f, 1.86563563e-02f, 1.04916561e-02f, -3.04810613e-01f, 7.29123712e-01f, 1.23790950e-01f, -9.47363734e-01f, -2.79415488e-01f, -2.30367512e-01f, 9.47148204e-01f, 8.75740528e-01f, 5.64642429e-01f, 3.31039310e-01f, 1.88600287e-01f, 1.06494442e-01f, 5.99640086e-02f, 3.37340795e-02f, 1.89725272e-02f, 1.06694745e-02f, -9.66117799e-01f, 2.51952261e-01f, 4.26245421e-01f, -9.89057720e-01f, -1.82162598e-01f, -2.84696162e-01f, 9.36531842e-01f, 8.84186864e-01f, 5.72867453e-01f, 3.36340427e-01f, 1.91704854e-01f, 1.08262435e-01f, 6.09621815e-02f, 3.42960916e-02f, 1.92886982e-02f, 1.08472919e-02f, -7.39180684e-01f, -3.02812874e-01f, 6.86427653e-01f, -9.99557257e-01f, -8.30891207e-02f, -3.38124752e-01f, 9.24979091e-01f, 8.92353535e-01f, 5.81035137e-01f, 3.41630876e-01f, 1.94807529e-01f, 1.10030092e-01f, 6.19602874e-02f, 3.48580964e-02f, 1.96048655e-02f, 1.10251084e-02f, 1.67355701e-01f, -7.64320076e-01f, 8.78538549e-01f, -9.78531301e-01f, 1.68140903e-02f, -3.90484393e-01f, 9.12501454e-01f, 9.00238097e-01f, 5.89144766e-01f, 3.46910536e-01f, 1.97908238e-01f, 1.11797392e-01f, 6.29583374e-02f, 3.54200937e-02f, 1.99210308e-02f, 1.12029258e-02f };

#define XB_TMO      128
#define XB_XCNT(j)  (256  + 64 * (j))
#define XB_XSUB(j)  (1280 + 64 * (j))
#define XB_XGEN(j)  (2304 + 64 * (j))
#define XB_TOP      3328
#define XB_TOPGEN   3392
#define XCD_BAR_WORDS 3456
#define XB_SPIN_CAP (1u << 18)

__device__ __forceinline__ unsigned xb_ld(unsigned* p)              { return __hip_atomic_load(p, __ATOMIC_RELAXED, __HIP_MEMORY_SCOPE_AGENT); }
__device__ __forceinline__ unsigned xb_add(unsigned* p, unsigned v) { return __hip_atomic_fetch_add(p, v, __ATOMIC_RELAXED, __HIP_MEMORY_SCOPE_AGENT); }
__device__ __forceinline__ unsigned xb_xcc_id() { return (unsigned)__builtin_amdgcn_s_getreg((3 << 11) | 20) & 0xFu; }
#define XB_SPIN(cond, bar) do { unsigned _sp = 0; while (cond) { __builtin_amdgcn_s_sleep(1); \
    if ((++_sp & 255u) == 0u) { if (xb_ld(&(bar)[XB_TMO])) break; if (_sp > XB_SPIN_CAP) { atomicAdd(&(bar)[XB_TMO], 1u); break; } } } } while (0)

struct XcdBarrier { unsigned* bar; unsigned x; volatile LAS unsigned* st; };

__device__ __forceinline__ XcdBarrier xcd_barrier_post(unsigned* bar, volatile LAS unsigned* st) {
    XcdBarrier b; b.bar = bar; b.x = xb_xcc_id(); b.st = st;
    if (threadIdx.x == 0) (void)xb_add(&bar[XB_XCNT(b.x)], 1u);
    return b;
}
__device__ __forceinline__ void xcd_barrier_complete(unsigned* bar, unsigned x, unsigned& nloc, unsigned& nx) {
    const unsigned G = gridDim.x * gridDim.y * gridDim.z;
    unsigned sum, cnt, mine, sp = 0u;
    for (;;) {
        sum = 0u; cnt = 0u; mine = 0u;
#pragma unroll
        for (unsigned j = 0; j < 16; ++j) { const unsigned c = xb_ld(&bar[XB_XCNT(j)]); sum += c; cnt += (c > 0u) ? 1u : 0u; mine = (j == x) ? c : mine; }
        if (sum == G) break;
        __builtin_amdgcn_s_sleep(1);
        if ((++sp & 255u) == 0u) { if (xb_ld(&bar[XB_TMO])) break; if (sp > XB_SPIN_CAP) { atomicAdd(&bar[XB_TMO], 1u); break; } }
    }
    nloc = mine > 0u ? mine : 1u; nx = cnt > 0u ? cnt : 1u;
}
__device__ __forceinline__ void xcd_barrier(const XcdBarrier& b) {
    asm volatile("s_waitcnt vmcnt(0)" ::: "memory");
    __syncthreads();
    if (threadIdx.x == 0) {
        unsigned* bar = b.bar;
        __builtin_amdgcn_s_waitcnt(0);
        unsigned nloc = b.st[0], nx = b.st[1];
        if (nloc == 0u) { xcd_barrier_complete(bar, b.x, nloc, nx); b.st[0] = nloc; b.st[1] = nx; }
        const unsigned old = xb_add(&bar[XB_XSUB(b.x)], 1u);
        const unsigned gen = old / nloc;
        if (old + 1u == (gen + 1u) * nloc) {
            __builtin_amdgcn_fence(__ATOMIC_RELEASE, "agent");
            asm volatile("s_waitcnt vmcnt(0)" ::: "memory");
            const unsigned og = xb_add(&bar[XB_TOP], 1u);
            const unsigned tg = og / nx;
            if (og + 1u == (tg + 1u) * nx) xb_add(&bar[XB_TOPGEN], 1u);
            else XB_SPIN(xb_ld(&bar[XB_TOPGEN]) == tg, bar);
            __builtin_amdgcn_fence(__ATOMIC_ACQUIRE, "agent");
            xb_add(&bar[XB_XGEN(b.x)], 1u);
            asm volatile("s_waitcnt vmcnt(0)" ::: "memory");
        } else {
            XB_SPIN(xb_ld(&bar[XB_XGEN(b.x)]) == gen, bar);
            __builtin_amdgcn_fence(__ATOMIC_ACQUIRE, "agent");
            asm volatile("s_waitcnt vmcnt(0)" ::: "memory");
        }
    }
    __syncthreads();
}

namespace pg8 {
constexpr int BM = 256, BK = 64, HALF = 128, HTB = HALF * BK * 2, STAGE_BYTES = 8 * HTB, NXCD = 8, WGM = 8;
__host__ __device__ __forceinline__ int lds_byte(int r, int c) { const int st = (r >> 4) * 2 + (c >> 5), rr = r & 15, cc = c & 31, ob = rr * 64 + cc * 2; return st * 1024 + (ob ^ (((ob >> 9) & 1) << 5)); }
__host__ __device__ __forceinline__ void stage_rc(int b, int& R, int& C) { const int st = b / 1024, sb = b % 1024, swz = sb ^ (((sb >> 9) & 1) << 5); R = (st >> 1) * 16 + swz / 64; C = (st & 1) * 32 + (swz % 64) / 2; }
__host__ __device__ __forceinline__ int perm32(int rho) { const int n = rho >> 4, i = rho & 15; return 8 * (i >> 2) + 4 * n + (i & 3); }

struct Unit { int pm, pn, kt0, nt, sp; };
struct Gemm { const bf16* A; const bf16* Bt; int lda, ldb, K; };

struct StaticOrder {
    int nM, nN, nwg, G, c, ntk, wgm;
    __host__ __device__ void init(int M, int N, int G_, int c_) { nM = M / BM; nN = N / BM; nwg = nM * nN; G = G_; c = c_; ntk = 0; wgm = WGM; }
    __host__ __device__ bool next(int i, Unit& u) const {
        const long L = (long)i * G + c; if (L >= nwg) return false;
        int wgid = (int)L; { const int q = nwg / NXCD, r = nwg % NXCD, xcd = wgid % NXCD, off = wgid / NXCD; wgid = (xcd < r ? xcd * (q + 1) : r * (q + 1) + (xcd - r) * q) + off; }
        const int nig = wgm * nN, gid = wgid / nig, fm = gid * wgm, gsz = (nM - fm) < wgm ? (nM - fm) : wgm;
        u.pm = fm + ((wgid % nig) % gsz); u.pn = (wgid % nig) / gsz; u.kt0 = 0; u.nt = ntk; u.sp = 0; return true;
    }
};
struct TailSplitOrder {
    StaticOrder lat; int G, c, ntk, ctx;
    __host__ __device__ void init(int K, int G_, int c_, int ctx_, int wgm_ = WGM) { lat.init(64 * BM, 8 * BM, G_, c_); lat.ntk = K / BK; lat.wgm = wgm_; G = G_; c = c_; ntk = K / BK; ctx = ctx_; }
    __host__ __device__ bool next(int i, Unit& u) const {
        const bool stag = ctx && G == 256 && (c & 1);
        long L2;
        if (stag) { if (i > 0) return lat.next(i - 1, u); L2 = c; }
        else { if (lat.next(i, u)) return true; if (!ctx) return false; L2 = (long)i * G + c - 512; }
        if (L2 < 0 || L2 >= 256) return false;
        const int cu = (int)L2 >> 3, sp = (int)L2 & 7, np = ntk >> 1;
        const int p0 = (sp * np) >> 3, p1 = ((sp + 1) * np) >> 3;
        u.pm = 64 + (cu & 3); u.pn = cu >> 2; u.kt0 = 2 * p0; u.nt = 2 * (p1 - p0); u.sp = sp; return true;
    }
};

__device__ __forceinline__ unsigned cvt_pk_bf16(float lo, float hi) { unsigned r; asm volatile("v_cvt_pk_bf16_f32 %0, %1, %2" : "=v"(r) : "v"(lo), "v"(hi)); return r; }

template <class Epi, class Sched>
__device__ __forceinline__ void gemm_phase(LAS unsigned char* lds, const int tid, const Gemm g, const Sched& S, const Epi& E) {
    const int wid = __builtin_amdgcn_readfirstlane(tid >> 6), lane = tid & 63, wr = wid >> 2, wc = wid & 3, fr = lane & 15, fq = lane >> 4;
    unsigned voffA[2], voffB[2];
#pragma unroll
    for (int i = 0; i < 2; ++i) { int R, C; stage_rc(tid * 16 + i * 8192, R, C); const int Rb = Epi::PERM ? ((R & ~31) + perm32(R & 31)) : R;
        voffA[i] = (unsigned)(R * g.lda + C) * 2u; voffB[i] = (unsigned)(Rb * g.ldb + C) * 2u; }
    const size_t kstep = (size_t)(BK * 2);
    const size_t hstepA = (size_t)HALF * g.lda * 2, hstepB = (size_t)HALF * g.ldb * 2;
    const size_t tstepA = 2 * hstepA, tstepB = 2 * hstepB;
    const unsigned ldsw = (unsigned)wid * 1024u;
    const int aoff = lds_byte(wr * 64 + fr, fq * 8), boff = lds_byte(wc * 32 + fr, fq * 8);
#define PG8_SA(b, h) (((b) * 2 + (h)) * HTB)
#define PG8_SB(b, h) ((4 + (b) * 2 + (h)) * HTB)
#define PG8_STAGE(bufoff, gbase, voff) do { _Pragma("unroll") for (int _i = 0; _i < 2; ++_i) \
        __builtin_amdgcn_global_load_lds((const unsigned*)((const char*)(gbase) + (voff)[_i]), (LAS unsigned*)(lds + (bufoff) + ldsw + _i * 8192), 16, 0, 0); } while (0)
#define PG8_LDA(dst, b, h) do { _Pragma("unroll") for (int m = 0; m < 4; ++m) _Pragma("unroll") for (int k = 0; k < 2; ++k) dst[m][k] = *(const LAS bf16x8*)(lds + PG8_SA(b, h) + aoff + m * 2048 + k * 1024); } while (0)
#define PG8_LDB(dst, b, h) do { _Pragma("unroll") for (int n = 0; n < 2; ++n) _Pragma("unroll") for (int k = 0; k < 2; ++k) dst[n][k] = *(const LAS bf16x8*)(lds + PG8_SB(b, h) + boff + n * 2048 + k * 1024); } while (0)
#define PG8_MMA(ai, bj, At, Bt) do { __builtin_amdgcn_s_setprio(1); _Pragma("unroll") for (int m = 0; m < 4; ++m) _Pragma("unroll") for (int n = 0; n < 2; ++n) _Pragma("unroll") for (int k = 0; k < 2; ++k) \
        acc[ai][bj][m][n] = __builtin_amdgcn_mfma_f32_16x16x32_bf16(Bt[n][k], At[m][k], acc[ai][bj][m][n], 0, 0, 0); __builtin_amdgcn_s_setprio(0); } while (0)
#define PG8_WAIT_V(n) asm volatile("s_waitcnt vmcnt(" #n ")" ::: "memory")
#define PG8_WAIT_L(n) asm volatile("s_waitcnt lgkmcnt(" #n ")" ::: "memory")
#define PG8_BAR __builtin_amdgcn_s_barrier()
#define PG8_SCHED __builtin_amdgcn_sched_barrier(0)
    Unit cur, nxt; int ui = 0;
    if (!S.next(0, cur)) return;
    f32x4 acc[2][2][4][2];
#pragma unroll
    for (int a = 0; a < 2; ++a)
#pragma unroll
        for (int b = 0; b < 2; ++b)
#pragma unroll
            for (int m = 0; m < 4; ++m)
#pragma unroll
                for (int n = 0; n < 2; ++n) acc[a][b][m][n] = (f32x4){0.f, 0.f, 0.f, 0.f};
    bf16x8 At[4][2], B0[2][2], B1[2][2];
    const char* cA = (const char*)g.A + (size_t)cur.pm * tstepA + (size_t)cur.kt0 * kstep; const char* cB = (const char*)g.Bt + (size_t)cur.pn * tstepB + (size_t)cur.kt0 * kstep;
    PG8_STAGE(PG8_SB(0, 0), cB, voffB); PG8_STAGE(PG8_SB(0, 1), cB + hstepB, voffB); PG8_STAGE(PG8_SA(0, 0), cA, voffA); PG8_STAGE(PG8_SA(0, 1), cA + hstepA, voffA);
    if (wr == 1) PG8_BAR;
    PG8_WAIT_V(2); PG8_BAR;
    PG8_STAGE(PG8_SB(1, 0), cB + kstep, voffB); PG8_STAGE(PG8_SA(1, 0), cA + kstep, voffA); PG8_STAGE(PG8_SB(1, 1), cB + hstepB + kstep, voffB);
    PG8_WAIT_V(6); PG8_BAR;
    for (;;) {
        const bool has_next = S.next(ui + 1, nxt);
        const char* nA = has_next ? (const char*)g.A + (size_t)nxt.pm * tstepA + (size_t)nxt.kt0 * kstep : cA; const char* nB = has_next ? (const char*)g.Bt + (size_t)nxt.pn * tstepB + (size_t)nxt.kt0 * kstep : cB;
        const int nt = cur.nt;
        for (int t = 0; t < nt; t += 2) {
            const bool last = (t == nt - 2);
            const char* a1 = cA + (size_t)(t + 1) * kstep;
            const char* a2 = last ? nA : cA + (size_t)(t + 2) * kstep; const char* b2 = last ? nB : cB + (size_t)(t + 2) * kstep;
            const char* a3 = a2 + kstep; const char* b3 = b2 + kstep;
            PG8_LDB(B0, 0, 0); PG8_LDB(B1, 0, 1); PG8_SCHED; PG8_LDA(At, 0, 0); PG8_STAGE(PG8_SA(1, 1), a1 + hstepA, voffA);
            PG8_WAIT_V(8); PG8_WAIT_L(0); PG8_BAR; PG8_MMA(0, 0, At, B0); PG8_MMA(0, 1, At, B1); PG8_BAR; PG8_SCHED;
            PG8_LDA(At, 0, 1); PG8_STAGE(PG8_SB(0, 0), b2, voffB); PG8_STAGE(PG8_SB(0, 1), b2 + hstepB, voffB); PG8_STAGE(PG8_SA(0, 0), a2, voffA);
            PG8_WAIT_V(8); PG8_WAIT_L(0); PG8_BAR; PG8_MMA(1, 0, At, B0); PG8_MMA(1, 1, At, B1); PG8_BAR; PG8_SCHED;
            PG8_LDB(B0, 1, 0); PG8_LDB(B1, 1, 1); PG8_SCHED; PG8_LDA(At, 1, 0); PG8_STAGE(PG8_SA(0, 1), a2 + hstepA, voffA);
            PG8_WAIT_V(8); PG8_WAIT_L(0); PG8_BAR; PG8_MMA(0, 0, At, B0); PG8_MMA(0, 1, At, B1); PG8_BAR; PG8_SCHED;
            PG8_LDA(At, 1, 1); PG8_STAGE(PG8_SB(1, 0), b3, voffB); PG8_STAGE(PG8_SB(1, 1), b3 + hstepB, voffB); PG8_STAGE(PG8_SA(1, 0), a3, voffA);
            PG8_WAIT_V(8); PG8_WAIT_L(0); PG8_BAR; PG8_MMA(1, 0, At, B0); PG8_MMA(1, 1, At, B1); PG8_BAR; PG8_SCHED;
        }
        if (wr == 0) PG8_BAR;
        E(acc, cur, wr, wc, fr, fq);
        if (!has_next) break;
#pragma unroll
        for (int a = 0; a < 2; ++a)
#pragma unroll
            for (int b = 0; b < 2; ++b)
#pragma unroll
                for (int m = 0; m < 4; ++m)
#pragma unroll
                    for (int n = 0; n < 2; ++n) acc[a][b][m][n] = (f32x4){0.f, 0.f, 0.f, 0.f};
        cur = nxt; cA = nA; cB = nB; ++ui;
        if (wr == 1) PG8_BAR;
    }
    PG8_WAIT_V(0);
    PG8_BAR;
#undef PG8_SA
#undef PG8_SB
#undef PG8_STAGE
#undef PG8_LDA
#undef PG8_LDB
#undef PG8_MMA
#undef PG8_WAIT_V
#undef PG8_WAIT_L
#undef PG8_BAR
#undef PG8_SCHED
}

__device__ __forceinline__ float silu_fast(float x) { return x * __builtin_amdgcn_rcpf(1.f + __builtin_amdgcn_exp2f(-x * 1.4426950408889634f)); }

struct EpiSwiGLU {
    static constexpr bool PERM = true;
    bf16* O; int ldc;
    __device__ __forceinline__ void operator()(const f32x4 (&acc)[2][2][4][2], const Unit& u, int wr, int wc, int fr, int fq) const {
        const int row0 = u.pm * BM + wr * 64 + fr, col0 = u.pn * HALF + wc * 32 + 8 * fq;
#pragma unroll
        for (int ai = 0; ai < 2; ++ai)
#pragma unroll
            for (int m = 0; m < 4; ++m) {
                bf16* rowp = O + (size_t)(row0 + ai * HALF + m * 16) * ldc + col0;
                const f32x4 g0 = acc[ai][0][m][0], g1 = acc[ai][0][m][1], u0 = acc[ai][1][m][0], u1 = acc[ai][1][m][1];
                f32x4 e0 = g0 * -1.4426950408889634f, e1 = g1 * -1.4426950408889634f;
#pragma unroll
                for (int q = 0; q < 4; ++q) { e0[q] = __builtin_amdgcn_exp2f(e0[q]); e1[q] = __builtin_amdgcn_exp2f(e1[q]); }
                e0 = e0 + 1.f; e1 = e1 + 1.f;
#pragma unroll
                for (int q = 0; q < 4; ++q) { e0[q] = __builtin_amdgcn_rcpf(e0[q]); e1[q] = __builtin_amdgcn_rcpf(e1[q]); }
                const f32x4 r0 = (g0 * u0) * e0, r1 = (g1 * u1) * e1;
                u32x4 w;
                w.x = cvt_pk_bf16(r0[0], r0[1]); w.y = cvt_pk_bf16(r0[2], r0[3]); w.z = cvt_pk_bf16(r1[0], r1[1]); w.w = cvt_pk_bf16(r1[2], r1[3]);
                *(u32x4*)rowp = w;
            }
    }
};
struct EpiResid {
    static constexpr bool PERM = true;
    bf16* H; const float* modl; int gidx; float coef; int ntk; bf16* part;
    __device__ __forceinline__ void operator()(const f32x4 (&acc)[2][2][4][2], const Unit& u, int wr, int wc, int fr, int fq) const {
        const int row0 = u.pm * BM + wr * 64 + fr, colt = u.pn * BM + wc * 32 + 8 * fq;
        if (u.nt != ntk) {
            bf16* pp = part + ((size_t)u.sp * MC + (row0 - ML)) * D + colt;
#pragma unroll
            for (int ai = 0; ai < 2; ++ai)
#pragma unroll
                for (int m = 0; m < 4; ++m)
#pragma unroll
                    for (int bj = 0; bj < 2; ++bj) { const f32x4 a0 = acc[ai][bj][m][0], a1 = acc[ai][bj][m][1];
                        u32x4 w; w.x = cvt_pk_bf16(a0[0], a0[1]); w.y = cvt_pk_bf16(a0[2], a0[3]); w.z = cvt_pk_bf16(a1[0], a1[1]); w.w = cvt_pk_bf16(a1[2], a1[3]);
                        *(u32x4*)(pp + (size_t)(ai * HALF + m * 16) * D + bj * HALF) = w; }
            return;
        }
        const int bid = u.pm < 64 ? (u.pm >> 4) : 4;
        const float* gate = modl + (size_t)bid * NMODV + gidx * 2048 + colt;
        f32x4 gv[2][2];
#pragma unroll
        for (int bj = 0; bj < 2; ++bj)
#pragma unroll
            for (int n = 0; n < 2; ++n) gv[bj][n] = *(const f32x4*)(gate + bj * HALF + 4 * n);
#pragma unroll
        for (int ai = 0; ai < 2; ++ai) {
            u32x4 hw[4][2];
#pragma unroll
            for (int m = 0; m < 4; ++m) { const bf16* rowp = H + (size_t)(row0 + ai * HALF + m * 16) * D + colt;
#pragma unroll
                for (int bj = 0; bj < 2; ++bj) hw[m][bj] = *(const u32x4*)(rowp + bj * HALF); }
            if (ai == 0) {
#pragma unroll
                for (int bj = 0; bj < 2; ++bj)
#pragma unroll
                    for (int n = 0; n < 2; ++n) gv[bj][n] = gv[bj][n] * coef;
            }
#pragma unroll
            for (int m = 0; m < 4; ++m) { bf16* rowp = H + (size_t)(row0 + ai * HALF + m * 16) * D + colt;
#pragma unroll
                for (int bj = 0; bj < 2; ++bj) { const u32x4 h4 = hw[m][bj];
                    const f32x4 v0 = (f32x4){bflo(h4.x), bfhi(h4.x), bflo(h4.y), bfhi(h4.y)} + gv[bj][0] * acc[ai][bj][m][0];
                    const f32x4 v1 = (f32x4){bflo(h4.z), bfhi(h4.z), bflo(h4.w), bfhi(h4.w)} + gv[bj][1] * acc[ai][bj][m][1];
                    u32x4 o; o.x = cvt_pk_bf16(v0[0], v0[1]); o.y = cvt_pk_bf16(v0[2], v0[3]); o.z = cvt_pk_bf16(v1[0], v1[1]); o.w = cvt_pk_bf16(v1[2], v1[3]);
                    *(u32x4*)(rowp + bj * HALF) = o; } }
        }
    }
};
struct EpiBf16 {
    static constexpr bool PERM = true;
    bf16* O; int ldc; const float* rs; const float* cs; int remap;
    __device__ __forceinline__ void operator()(const f32x4 (&acc)[2][2][4][2], const Unit& u, int wr, int wc, int fr, int fq) const {
        const int row0 = u.pm * BM + wr * 64 + fr, colt = u.pn * BM + wc * 32 + 8 * fq;
        float sr[2][4]; f32x4 cc[2][2];
#pragma unroll
        for (int ai = 0; ai < 2; ++ai)
#pragma unroll
            for (int m = 0; m < 4; ++m) sr[ai][m] = rs ? rs[row0 + ai * HALF + m * 16] : 1.f;
#pragma unroll
        for (int bj = 0; bj < 2; ++bj) { const int c = colt + bj * HALF; cc[bj][0] = (f32x4){1.f, 1.f, 1.f, 1.f}; cc[bj][1] = cc[bj][0];
            if (cs) { cc[bj][0] = *(const f32x4*)(cs + c); cc[bj][1] = *(const f32x4*)(cs + c + 4); } }
#pragma unroll
        for (int bj = 0; bj < 2; ++bj) {
            const int c = colt + bj * HALF, oc = remap ? ((c >> 6) * 96 + (c & 63)) : c;
            const f32x4 c0 = cc[bj][0], c1 = cc[bj][1];
#pragma unroll
            for (int ai = 0; ai < 2; ++ai)
#pragma unroll
                for (int m = 0; m < 4; ++m) { const int r = row0 + ai * HALF + m * 16; const float s = sr[ai][m];
                    const f32x4 v0 = acc[ai][bj][m][0] * c0 * s, v1 = acc[ai][bj][m][1] * c1 * s;
                    u32x4 w; w.x = cvt_pk_bf16(v0[0], v0[1]); w.y = cvt_pk_bf16(v0[2], v0[3]); w.z = cvt_pk_bf16(v1[0], v1[1]); w.w = cvt_pk_bf16(v1[2], v1[3]);
                    *(u32x4*)(O + (size_t)r * ldc + oc) = w; }
        }
    }
};
}

struct Frame {
    LAS unsigned char* lds;
    int tid, lane, wave, vcu, G;
    unsigned char* ws; float* out;
};
__device__ __forceinline__ Frame fresh(const Frame& F0) {
    Frame F = F0;
    asm volatile("" : "+v"(F.tid), "+v"(F.lane));
    asm volatile("" : "+s"(F.wave), "+s"(F.vcu), "+s"(F.G));
    asm volatile("" : "+s"(F.ws), "+s"(F.out));
    F.ws = (unsigned char*)(GAS unsigned char*)(unsigned long long)F.ws; F.out = (float*)(GAS float*)(unsigned long long)F.out;
    return F;
}
constexpr int PTAB_OFF = LDSCTL_OFF + 1024;
__device__ __forceinline__ const float* inp_ptr(const Frame& F, int i) {
    const LAS unsigned* p = (const LAS unsigned*)(F.lds + PTAB_OFF) + 2 * i;
    const unsigned lo = __builtin_amdgcn_readfirstlane(p[0]), hi = __builtin_amdgcn_readfirstlane(p[1]);
    return (const float*)(const GAS float*)(((unsigned long long)hi << 32) | lo);
}
#define INP(i) inp_ptr(F, (i))
enum { I_X = 0, I_C, I_CTX, I_CCTX, I_WMOD, I_BMOD, I_NORMG, I_WGATE, I_WUP, I_WDOWN, I_WIN, I_WOUT, I_CONVW, I_CONVB, I_DTB, I_ALOG, I_DSKIP, I_SSDN,
       I_QNORM, I_WUQ, I_KVNORM, I_WUKV, I_MLAON, I_SINK, I_SWAON, I_FNORM };

struct RowMap { bf16* b0; bf16* b1; int mode; int ldd; };
__device__ __forceinline__ bf16* rowmap(const RowMap& r, int n) {
    if (r.mode == 0) return r.b0 + (size_t)n * r.ldd;
    if (r.mode == 1) return r.b0 + (size_t)((n >> 7) * 256 + (n & 127)) * r.ldd;
    if (r.mode == 2) return r.b0 + (size_t)((n >> 7) * 256 + 128 + (n & 127)) * r.ldd;
    const int h = n >> 7, j = n & 127;
    return j < 64 ? r.b0 + (size_t)(h * 64 + j) * r.ldd : r.b1 + (size_t)(h * 64 + j - 64) * r.ldd;
}
__device__ __forceinline__ void cvt_item(const float* W, int N, int nblk, int item, const RowMap& rm, const float* ksc, LAS float* scr, int lane) {
    const int kb = item / nblk, nb = item % nblk, k0 = 64 * kb, n0 = 32 * nb;
    {
        float v[32];
#pragma unroll
        for (int i = 0; i < 32; ++i) v[i] = __builtin_nontemporal_load(&W[(size_t)(k0 + 2 * i + (lane >> 5)) * N + n0 + (lane & 31)]);
        if (ksc) {
            float kv[32];
#pragma unroll
            for (int i = 0; i < 32; ++i) kv[i] = ksc[k0 + 2 * i + (lane >> 5)];
#pragma unroll
            for (int i = 0; i < 32; ++i) v[i] *= kv[i];
        }
#pragma unroll
        for (int i = 0; i < 32; ++i) scr[(2 * i + (lane >> 5)) * 33 + (lane & 31)] = v[i];
    }
    LDS_WAIT(); asm volatile("" ::: "memory");
    const int c = lane & 7;
#pragma unroll
    for (int j = 0; j < 4; ++j) { const int n = (lane >> 3) + 8 * j; const LAS float* s = scr + (8 * c) * 33 + n;
        u32x4 o; o.x = pk2(s[0 * 33], s[1 * 33]); o.y = pk2(s[2 * 33], s[3 * 33]); o.z = pk2(s[4 * 33], s[5 * 33]); o.w = pk2(s[6 * 33], s[7 * 33]);
        *(u32x4*)(rowmap(rm, n0 + n) + k0 + 8 * c) = o; }
    LDS_WAIT(); asm volatile("" ::: "memory");
}
__device__ __forceinline__ void cvt_load(const float* W, int N, int nblk, int item, float (&v)[32], int lane) {
    const int kb = item / nblk, nb = item % nblk, k0 = 64 * kb, n0 = 32 * nb;
#pragma unroll
    for (int i = 0; i < 32; ++i) v[i] = __builtin_nontemporal_load(&W[(size_t)(k0 + 2 * i + (lane >> 5)) * N + n0 + (lane & 31)]);
}
__device__ __forceinline__ void cvt_finish(const float (&v)[32], int nblk, int item, const RowMap& rm, LAS float* scr, int lane) {
    const int kb = item / nblk, nb = item % nblk, k0 = 64 * kb, n0 = 32 * nb;
#pragma unroll
    for (int i = 0; i < 32; ++i) scr[(2 * i + (lane >> 5)) * 33 + (lane & 31)] = v[i];
    LDS_WAIT(); asm volatile("" ::: "memory");
    const int c = lane & 7;
#pragma unroll
    for (int j = 0; j < 4; ++j) { const int n = (lane >> 3) + 8 * j; const LAS float* s = scr + (8 * c) * 33 + n;
        u32x4 o; o.x = pk2(s[0 * 33], s[1 * 33]); o.y = pk2(s[2 * 33], s[3 * 33]); o.z = pk2(s[4 * 33], s[5 * 33]); o.w = pk2(s[6 * 33], s[7 * 33]);
        *(u32x4*)(rowmap(rm, n0 + n) + k0 + 8 * c) = o; }
    LDS_WAIT(); asm volatile("" ::: "memory");
}
__device__ __forceinline__ void bg_convert(const Frame& F, int kind, int lf, int rank, int nidle) {
    LAS float* scr = (LAS float*)(F.lds + F.wave * 16384);
    constexpr int I_GU = 32 * 176, I_DN = 88 * 64, I_INW = 32 * 126, I_OUTW = 32 * 64;
    const bool gu = (kind == 0 || kind >= 3);
    const int nit = kind == 0 ? 2 * I_GU : kind == 1 ? I_DN : kind == 2 ? I_INW + I_OUTW : I_GU, nw = nidle * NWAVES;
#define BG_DESC(it_) const int up_ = (kind == 0 && (it_) >= I_GU) || (kind == 2 && (it_) >= I_INW) || kind == 4; \
        const int r_ = kind == 0 ? (up_ ? (it_) - I_GU : (it_)) : kind == 2 ? (up_ ? (it_) - I_INW : (it_)) : (it_); \
        const float* W_ = gu ? (up_ ? INP(I_WUP) : INP(I_WGATE)) + (size_t)lf * D * DFF : kind == 1 ? INP(I_WDOWN) + (size_t)lf * DFF * D : up_ ? INP(I_WOUT) + (size_t)lf * D * D : INP(I_WIN) + (size_t)lf * D * DIN; \
        const int N_ = gu ? DFF : kind == 1 ? D : up_ ? D : DIN, nblk_ = gu ? 176 : kind == 1 ? 64 : up_ ? 64 : 126;
    int it = rank * NWAVES + F.wave;
    float cur[32];
    if (it < nit) { BG_DESC(it) cvt_load(W_, N_, nblk_, r_, cur, F.lane); }
    for (; it < nit; it += nw) {
        const int itn = (it + nw < nit) ? it + nw : it;
        float nx[32];
        { BG_DESC(itn) cvt_load(W_, N_, nblk_, r_, nx, F.lane); }
        { BG_DESC(it)
          const RowMap rm = gu ? RowMap{((bf16*)(F.ws + WS_WGU)) + (size_t)lf * 11264 * D, nullptr, up_ ? 2 : 1, D}
                          : kind == 1 ? RowMap{((bf16*)(F.ws + WS_WD)) + (size_t)lf * D * DFF, nullptr, 0, DFF}
                          : up_ ? RowMap{((bf16*)(F.ws + WS_WOUT)) + (size_t)lf * D * D, nullptr, 0, D} : RowMap{((bf16*)(F.ws + WS_WIN)) + (size_t)lf * DINP * D, nullptr, 0, D};
          (void)W_; (void)N_;
          cvt_finish(cur, nblk_, r_, rm, scr, F.lane); }
#pragma unroll
        for (int i = 0; i < 32; ++i) cur[i] = nx[i];
    }
#undef BG_DESC
}
__device__ __forceinline__ bool bg_deferred_gu(int lf) { return lf >= 1; }
__device__ __forceinline__ bool bg_deferred_dn(int lf) { return lf >= 1; }
__device__ __forceinline__ void ph_prologue(const Frame& F) {
    const size_t gtid = (size_t)F.vcu * 512 + F.tid, gth = (size_t)F.G * 512;
    {
        const f32x4* x4 = (const f32x4*)INP(I_X); const f32x4* c4 = (const f32x4*)INP(I_CTX); u32x2* h2 = (u32x2*)(F.ws + WS_H);
        const size_t nx = (size_t)ML * D / 4, nc = (size_t)MC * D / 4;
        const size_t tot = nx + nc;
        for (size_t i0 = gtid; i0 < tot; i0 += 8 * gth) {
            f32x4 v[8];
#pragma unroll
            for (int u = 0; u < 8; ++u) { const size_t i = i0 + u * gth, ic = i < tot ? i : tot - 1; const f32x4* src = ic < nx ? x4 + ic : c4 + (ic - nx); v[u] = __builtin_nontemporal_load(src); }
#pragma unroll
            for (int u = 0; u < 8; ++u) { const size_t i = i0 + u * gth; if (i < tot) { u32x2 w; w.x = pk2(v[u].x, v[u].y); w.y = pk2(v[u].z, v[u].w); h2[i] = w; } }
        }
    }
    for (size_t i = gtid; i < (size_t)DEPTH * 16384; i += gth) {
        const size_t l = i / 16384, r = i % 16384; ((u32x4*)(((bf16*)(F.ws + WS_WIN)) + (l * DINP + DIN) * D))[r] = (u32x4){0u, 0u, 0u, 0u};
    }
    LAS float* scr = (LAS float*)(F.lds + F.wave * 16384);
    const int gw = F.vcu * NWAVES + F.wave, NGW = F.G * NWAVES;
    constexpr int I_GU = 32 * 176, I_DN = 88 * 64, I_INW = 32 * 126, I_OUTW = 32 * 64, I_UQ = 6 * 24, I_UKV = 4 * 32;
    constexpr int N_A = 8 * I_GU, N_B = 8 * I_GU, N_C = 8 * I_DN, N_D = 4 * I_INW, N_E = 4 * I_OUTW, N_F = 4 * I_UQ, N_G = 4 * I_UKV;
    constexpr int NITEMS = N_A + N_B + N_C + N_D + N_E + N_F + N_G;
    for (int it = gw; it < NITEMS; it += NGW) {
        int r = it;
        if (r < N_A) { const int lf = r / I_GU; if (bg_deferred_gu(lf)) continue; RowMap rm{((bf16*)(F.ws + WS_WGU)) + (size_t)lf * 11264 * D, nullptr, 1, D}; cvt_item(INP(I_WGATE) + (size_t)lf * D * DFF, DFF, 176, r % I_GU, rm, nullptr, scr, F.lane); continue; } r -= N_A;
        if (r < N_B) { const int lf = r / I_GU; if (bg_deferred_gu(lf)) continue; RowMap rm{((bf16*)(F.ws + WS_WGU)) + (size_t)lf * 11264 * D, nullptr, 2, D}; cvt_item(INP(I_WUP) + (size_t)lf * D * DFF, DFF, 176, r % I_GU, rm, nullptr, scr, F.lane); continue; } r -= N_B;
        if (r < N_C) { const int lf = r / I_DN; if (bg_deferred_dn(lf)) continue; RowMap rm{((bf16*)(F.ws + WS_WD)) + (size_t)lf * D * DFF, nullptr, 0, DFF}; cvt_item(INP(I_WDOWN) + (size_t)lf * DFF * D, D, 64, r % I_DN, rm, nullptr, scr, F.lane); continue; } r -= N_C;
        if (r < N_D) { const int l = r / I_INW; if (l >= 1) continue; RowMap rm{((bf16*)(F.ws + WS_WIN)) + (size_t)l * DINP * D, nullptr, 0, D}; cvt_item(INP(I_WIN) + (size_t)l * D * DIN, DIN, 126, r % I_INW, rm, nullptr, scr, F.lane); continue; } r -= N_D;
        if (r < N_E) { const int l = r / I_OUTW; if (l >= 1) continue; RowMap rm{((bf16*)(F.ws + WS_WOUT)) + (size_t)l * D * D, nullptr, 0, D}; cvt_item(INP(I_WOUT) + (size_t)l * D * D, D, 64, r % I_OUTW, rm, nullptr, scr, F.lane); continue; } r -= N_E;
        if (r < N_F) { const int l = r / I_UQ; RowMap rm{((bf16*)(F.ws + WS_WUQ)) + (size_t)l * 768 * 384, nullptr, 0, 384}; cvt_item(INP(I_WUQ) + (size_t)l * 384 * 768, 768, 24, r % I_UQ, rm, INP(I_QNORM) + l * 384, scr, F.lane); continue; } r -= N_F;
        { const int l = r / I_UKV; RowMap rm{((bf16*)(F.ws + WS_WUK)) + (size_t)l * 512 * 256, ((bf16*)(F.ws + WS_WUV)) + (size_t)l * 512 * 256, 3, 256}; cvt_item(INP(I_WUKV) + (size_t)l * 256 * 1024, 1024, 32, r % I_UKV, rm, INP(I_KVNORM) + l * 256, scr, F.lane); }
    }
    __syncthreads();
    LAS float* sv = (LAS float*)F.lds;
    for (int i = F.tid; i < 5 * D; i += 512) { const int r = i / D, k = i % D; const float c = r < 4 ? INP(I_C)[r * D + k] : INP(I_CCTX)[k]; sv[i] = silu_f(c); }
    __syncthreads();
    {
        const int per = (2304 + F.G - 1) / F.G, it0 = F.vcu * per, it1 = (it0 + per < 2304) ? it0 + per : 2304;
        f32x4 a0 = {0.f, 0.f, 0.f, 0.f}, a1 = a0, a2 = a0, a3 = a0, a4 = a0;
        for (int it = it0; it < it1; ++it) {
            const int B = it >> 6, kc = it & 63, l = B / 9, nc = B % 9;
            const float* w = INP(I_WMOD) + (size_t)l * D * NMODV + nc * 2048 + 4 * F.tid + (size_t)(kc * 32) * NMODV;
#pragma unroll
            for (int kb = 0; kb < 32; kb += 8) {
                f32x4 wv[8];
#pragma unroll
                for (int u = 0; u < 8; ++u) wv[u] = __builtin_nontemporal_load((const f32x4*)(w + (size_t)(kb + u) * NMODV));
#pragma unroll
                for (int u = 0; u < 8; ++u) { const int k = kc * 32 + kb + u; a0 += wv[u] * sv[k]; a1 += wv[u] * sv[D + k]; a2 += wv[u] * sv[2 * D + k]; a3 += wv[u] * sv[3 * D + k]; a4 += wv[u] * sv[4 * D + k]; }
            }
            if (it + 1 == it1 || ((it + 1) >> 6) != B) {
                const int piece = F.vcu - (64 * B) / per;
                float* o = ((float*)(F.ws + WS_HID)) + ((size_t)(B * 16 + piece) * 5) * 2048 + 4 * F.tid;
                *(f32x4*)(o) = a0; *(f32x4*)(o + 2048) = a1; *(f32x4*)(o + 2 * 2048) = a2; *(f32x4*)(o + 3 * 2048) = a3; *(f32x4*)(o + 4 * 2048) = a4;
                a0 = (f32x4){0.f, 0.f, 0.f, 0.f}; a1 = a0; a2 = a0; a3 = a0; a4 = a0;
            }
        }
    }
}
__device__ __forceinline__ void ph_modfinal(const Frame& F) {
    const size_t gtid = (size_t)F.vcu * 512 + F.tid, gth = (size_t)F.G * 512;
    const int per = (2304 + F.G - 1) / F.G;
    for (size_t i = gtid; i < (size_t)4 * 5 * NMODV; i += gth) {
        const int n = (int)(i % NMODV), lr = (int)(i / NMODV), l = lr / 5, r = lr % 5, B = l * 9 + (n >> 11);
        const int np = (64 * B + 63) / per - (64 * B) / per + 1;
        float s = INP(I_BMOD)[(size_t)l * NMODV + n];
        const float* pp = ((float*)(F.ws + WS_HID)) + ((size_t)(B * 16) * 5 + r) * 2048 + (n & 2047);
        float pv[16];
#pragma unroll
        for (int q = 0; q < 16; ++q) pv[q] = pp[(size_t)(q < np ? q : np - 1) * 5 * 2048];
#pragma unroll
        for (int q = 0; q < 16; ++q) s += q < np ? pv[q] : 0.f;
        ((float*)(F.ws + WS_MODV))[i] = s;
    }
}
__device__ __forceinline__ void ph_norm(const Frame& F, int l, int which, int pend_l, int pend_g, float pend_coef, int nrows) {
    const int gw = F.vcu * NWAVES + F.wave, NGW = F.G * NWAVES;
    LAS float* tab = (LAS float*)F.lds;
    {
        const float* g = INP(I_NORMG) + (size_t)(l * 3 + which) * D;
        for (int i = F.tid; i < 5 * (D / 4); i += 512) {
            const int bid = i / (D / 4), c = 4 * (i % (D / 4));
            const float* mv = ((float*)(F.ws + WS_MODV)) + ((size_t)l * 5 + bid) * NMODV + (size_t)(3 * which) * D;
            const f32x4 gg = *(const f32x4*)(g + c), sh = *(const f32x4*)(mv + c), sc = *(const f32x4*)(mv + D + c);
            *(LAS f32x4*)(tab + (bid * 2) * D + c) = gg * (sc + 1.f);
            *(LAS f32x4*)(tab + (bid * 2 + 1) * D + c) = sh;
        }
        __syncthreads();
    }
    u32x2 cur[8];
    { const u32x2* xr = (const u32x2*)(((bf16*)(F.ws + WS_H)) + (size_t)gw * D) + F.lane;
#pragma unroll
      for (int j = 0; j < 8; ++j) cur[j] = xr[64 * j]; }
    for (int m = gw; m < nrows; m += NGW) {
        const int mn = (m + NGW < nrows) ? m + NGW : m;
        u32x2 nx[8];
        { const u32x2* xn = (const u32x2*)(((bf16*)(F.ws + WS_H)) + (size_t)mn * D) + F.lane;
#pragma unroll
          for (int j = 0; j < 8; ++j) nx[j] = xn[64 * j]; }
        const int bid = m < ML ? (m >> 12) : 4;
        u32x2* xr = (u32x2*)(((bf16*)(F.ws + WS_H)) + (size_t)m * D) + F.lane;
        f32x4 v[8]; float s = 0.f;
#pragma unroll
        for (int j = 0; j < 8; ++j) { const u32x2 hw = cur[j]; v[j] = (f32x4){bflo(hw.x), bfhi(hw.x), bflo(hw.y), bfhi(hw.y)}; }
        if (m >= ML && pend_g >= 0) {
            const float* pg = ((float*)(F.ws + WS_MODV)) + ((size_t)pend_l * 5 + 4) * NMODV + (size_t)pend_g * D;
            const u32x2* pr = (const u32x2*)(((bf16*)(F.ws + WS_PART)) + (size_t)(m - ML) * D) + F.lane;
            u32x2 hws[8];
#pragma unroll
            for (int jj = 0; jj < 8; jj += 4) {
                u32x2 pw[4][8]; f32x4 gt[4];
#pragma unroll
                for (int jx = 0; jx < 4; ++jx) {
#pragma unroll
                    for (int sp = 0; sp < 8; ++sp) pw[jx][sp] = pr[(size_t)sp * MC * D / 4 + 64 * (jj + jx)];
                    gt[jx] = *(const f32x4*)(pg + 4 * F.lane + 256 * (jj + jx)); }
#pragma unroll
                for (int jx = 0; jx < 4; ++jx) { const int j = jj + jx; f32x4 a = {0.f, 0.f, 0.f, 0.f};
#pragma unroll
                    for (int sp = 0; sp < 8; ++sp) { const u32x2 w = pw[jx][sp]; a += (f32x4){bflo(w.x), bfhi(w.x), bflo(w.y), bfhi(w.y)}; }
                    v[j] += a * (gt[jx] * pend_coef);
                    u32x2 hw; hw.x = pk2(v[j].x, v[j].y); hw.y = pk2(v[j].z, v[j].w); hws[j] = hw;
                    v[j] = (f32x4){bflo(hw.x), bfhi(hw.x), bflo(hw.y), bfhi(hw.y)}; }
            }
#pragma unroll
            for (int j = 0; j < 8; ++j) xr[64 * j] = hws[j];
        }
#pragma unroll
        for (int j = 0; j < 8; ++j) s += (v[j].x * v[j].x + v[j].y * v[j].y) + (v[j].z * v[j].z + v[j].w * v[j].w);
        const float rstd = rsqrtf(wave_sum(s) * (1.f / D) + EPS);
        u32x2* o = (u32x2*)(((bf16*)(F.ws + WS_U)) + (size_t)m * D) + F.lane;
        const LAS float* ta = tab + (bid * 2) * D + 4 * F.lane;
#pragma unroll
        for (int j = 0; j < 8; ++j) {
            const f32x4 ga = *(const LAS f32x4*)(ta + 256 * j), sh = *(const LAS f32x4*)(ta + D + 256 * j);
            const f32x4 y = v[j] * rstd * ga + sh;
            u32x2 w; w.x = pk2(y.x, y.y); w.y = pk2(y.z, y.w); o[64 * j] = w;
        }
#pragma unroll
        for (int j = 0; j < 8; ++j) cur[j] = nx[j];
    }
}
__device__ __forceinline__ void ph_prep(const Frame& F, int l) {
    const int gw = F.vcu * NWAVES + F.wave, NGW = F.G * NWAVES, lane = F.lane;
    const bf16* P = ((bf16*)(F.ws + WS_P));
#define PR_LOAD(mm, Q0, Q1, KV, KR, KS0, KS1, VS0, VS1) do { const bf16* pr_ = P + (size_t)(mm) * DINP; \
        Q0 = *(const u32x2*)(pr_ + PC_CQ + 4 * lane); Q1 = *(const unsigned*)(pr_ + PC_CQ + 256 + 2 * lane); KV = *(const u32x2*)(pr_ + PC_CKV + 4 * lane); \
        KR = pr_[PC_KR + (lane & 31)]; KS0 = pr_[PC_KS + lane]; KS1 = pr_[PC_KS + 64 + lane]; VS0 = pr_[PC_VS + lane]; VS1 = pr_[PC_VS + 64 + lane]; } while (0)
    u32x2 cq0, nq0, ckv, nkv; unsigned cq1, nq1; bf16 ckr, nkr, cks0, nks0, cks1, nks1, cvs0, nvs0, cvs1, nvs1;
    PR_LOAD(gw, cq0, cq1, ckv, ckr, cks0, cks1, cvs0, cvs1);
    for (int m = gw; m < MT; m += NGW) {
        const int mn = (m + NGW < MT) ? m + NGW : m;
        int t, isl; if (m < ML) { t = m & 4095; isl = 1; } else { t = (m - ML) & 255; isl = 0; }
        float cs8, sn8, cs16, sn16;
        { const int pos8 = ((lane >> 4) & 1) ? (t & 63) : (t >> 6), pos16 = (lane >> 5) ? (t & 63) : (t >> 6);
          cs8 = ROPE_COS_8[pos8 * 8 + (lane & 7)]; sn8 = ROPE_SIN_8[pos8 * 8 + (lane & 7)]; cs16 = ROPE_COS_16[pos16 * 16 + (lane & 15)]; sn16 = ROPE_SIN_16[pos16 * 16 + (lane & 15)]; }
        PR_LOAD(mn, nq0, nq1, nkv, nkr, nks0, nks1, nvs0, nvs1);
        float sq = (bflo(cq0.x) * bflo(cq0.x) + bfhi(cq0.x) * bfhi(cq0.x)) + (bflo(cq0.y) * bflo(cq0.y) + bfhi(cq0.y) * bfhi(cq0.y)) + (bflo(cq1) * bflo(cq1) + bfhi(cq1) * bfhi(cq1));
        float sk = (bflo(ckv.x) * bflo(ckv.x) + bfhi(ckv.x) * bfhi(ckv.x)) + (bflo(ckv.y) * bflo(ckv.y) + bfhi(ckv.y) * bfhi(ckv.y));
        sq = wave_sum(sq); sk = wave_sum(sk);
        if (lane == 0) { ((float*)(F.ws + WS_RSTD))[m] = rsqrtf(sq * (1.f / 384.f) + EPS); ((float*)(F.ws + WS_RSTD))[MT + m] = rsqrtf(sk * (1.f / 256.f) + EPS); }
        {
            const float x = bf2f(ckr); const float px = __shfl_xor(x, 8); float o = x;
            if (isl) { const int idx = lane & 15; o = idx < 8 ? x * cs8 - px * sn8 : x * cs8 + px * sn8; }
            if (lane < 32) { const bf16 ob = (bf16)f2bf(o);
#pragma unroll
                for (int h = 0; h < 8; ++h) ((bf16*)(F.ws + WS_KM))[(size_t)m * 768 + h * 96 + 64 + lane] = ob; }
        }
#pragma unroll
        for (int gi = 0; gi < 2; ++gi) {
            const float x = bf2f(gi ? cks1 : cks0); const float px = __shfl_xor(x, 16); float o = x;
            if (isl) { const int idx = lane & 31; o = idx < 16 ? x * cs16 - px * sn16 : x * cs16 + px * sn16; }
            ((bf16*)(F.ws + WS_KS))[(size_t)m * 128 + gi * 64 + lane] = (bf16)f2bf(o);
            ((bf16*)(F.ws + WS_VST))[(size_t)(gi * 64 + lane) * MT + m] = gi ? cvs1 : cvs0;
        }
        cq0 = nq0; cq1 = nq1; ckv = nkv; ckr = nkr; cks0 = nks0; cks1 = nks1; cvs0 = nvs0; cvs1 = nvs1;
    }
#undef PR_LOAD
}
__device__ __forceinline__ void ph_outnorm(const Frame& F, int l) {
    const int gw = F.vcu * NWAVES + F.wave, NGW = F.G * NWAVES, lane = F.lane;
    const int nrows = l == DEPTH - 1 ? ML : MT;
    const float* gs = INP(I_SSDN) + l * 1024 + 4 * lane; const float* gm = INP(I_MLAON) + l * 512 + 4 * lane; const float* gq = INP(I_SWAON) + l * 512 + 4 * lane;
    f32x4 ggs[4], ggm[2], ggq[2];
#pragma unroll
    for (int j = 0; j < 4; ++j) ggs[j] = *(const f32x4*)(gs + 256 * j);
#pragma unroll
    for (int j = 0; j < 2; ++j) { ggm[j] = *(const f32x4*)(gm + 256 * j); ggq[j] = *(const f32x4*)(gq + 256 * j); }
#define ON_LOAD(mm, Y, A, B, Q) do { const u32x2* yg_ = (const u32x2*)(((bf16*)(F.ws + WS_YG)) + (size_t)(mm) * 1024) + lane; \
        const u32x2* mx_ = (const u32x2*)(((bf16*)(F.ws + WS_MX)) + (size_t)(mm) * 512) + lane; const u32x2* sx_ = (const u32x2*)(((bf16*)(F.ws + WS_SX)) + (size_t)(mm) * 512) + lane; \
        _Pragma("unroll") for (int j = 0; j < 4; ++j) Y[j] = __builtin_nontemporal_load(yg_ + 64 * j); \
        _Pragma("unroll") for (int j = 0; j < 2; ++j) { const u32x2 ma_ = __builtin_nontemporal_load(mx_ + 64 * j), sb_ = __builtin_nontemporal_load(sx_ + 64 * j); A[j] = (f32x4){bflo(ma_.x), bfhi(ma_.x), bflo(ma_.y), bfhi(ma_.y)}; B[j] = (f32x4){bflo(sb_.x), bfhi(sb_.x), bflo(sb_.y), bfhi(sb_.y)}; } \
        Q = ((float*)(F.ws + WS_SSQ))[(size_t)(mm) * 16 + (lane & 15)]; } while (0)
    u32x2 y[4], ny[4]; f32x4 a[2], b[2], na[2], nb[2]; float qv, nq;
    ON_LOAD(gw, y, a, b, qv);
    for (int m = gw; m < nrows; m += NGW) {
        const int mn = (m + NGW < nrows) ? m + NGW : m;
        ON_LOAD(mn, ny, na, nb, nq);
        const float q = (lane < 16) ? qv : 0.f;
        float q0 = lane < 8 ? q : 0.f, q1 = lane >= 8 ? q : 0.f, sa = 0.f, sb = 0.f;
#pragma unroll
        for (int j = 0; j < 2; ++j) { sa += (a[j].x * a[j].x + a[j].y * a[j].y) + (a[j].z * a[j].z + a[j].w * a[j].w); sb += (b[j].x * b[j].x + b[j].y * b[j].y) + (b[j].z * b[j].z + b[j].w * b[j].w); }
        q0 = wave_sum(q0); q1 = wave_sum(q1); sa = wave_sum(sa); sb = wave_sum(sb);
        const float r0 = rsqrtf(q0 * (1.f / 512.f) + EPS), r1 = rsqrtf(q1 * (1.f / 512.f) + EPS), ra = rsqrtf(sa * (1.f / 512.f) + EPS), rb = rsqrtf(sb * (1.f / 512.f) + EPS);
        u32x2* o = (u32x2*)(((bf16*)(F.ws + WS_OX)) + (size_t)m * D) + lane;
#pragma unroll
        for (int j = 0; j < 4; ++j) { const f32x4 gg = ggs[j]; const float r = j < 2 ? r0 : r1;
            u32x2 w; w.x = pk2(bflo(y[j].x) * r * gg.x, bfhi(y[j].x) * r * gg.y); w.y = pk2(bflo(y[j].y) * r * gg.z, bfhi(y[j].y) * r * gg.w); o[64 * j] = w; }
#pragma unroll
        for (int j = 0; j < 2; ++j) { const f32x4 v = a[j] * ra * ggm[j]; u32x2 w; w.x = pk2(v.x, v.y); w.y = pk2(v.z, v.w); o[256 + 64 * j] = w; }
#pragma unroll
        for (int j = 0; j < 2; ++j) { const f32x4 v = b[j] * rb * ggq[j]; u32x2 w; w.x = pk2(v.x, v.y); w.y = pk2(v.z, v.w); o[384 + 64 * j] = w; }
#pragma unroll
        for (int j = 0; j < 4; ++j) y[j] = ny[j];
#pragma unroll
        for (int j = 0; j < 2; ++j) { a[j] = na[j]; b[j] = nb[j]; }
        qv = nq;
    }
#undef ON_LOAD
}
__device__ __forceinline__ void ph_final(const Frame& F) {
    const int gw = F.vcu * NWAVES + F.wave, NGW = F.G * NWAVES;
    const float* g = INP(I_FNORM);
    u32x2 cur[8];
    { const u32x2* xr = (const u32x2*)(((bf16*)(F.ws + WS_H)) + (size_t)gw * D) + F.lane;
#pragma unroll
      for (int j = 0; j < 8; ++j) cur[j] = __builtin_nontemporal_load(xr + 64 * j); }
    f32x4 gg[8];
#pragma unroll
    for (int j = 0; j < 8; ++j) gg[j] = *(const f32x4*)(g + 4 * F.lane + 256 * j);
    for (int m = gw; m < ML; m += NGW) {
        const int mn = (m + NGW < ML) ? m + NGW : m;
        u32x2 nx[8];
        { const u32x2* xn = (const u32x2*)(((bf16*)(F.ws + WS_H)) + (size_t)mn * D) + F.lane;
#pragma unroll
          for (int j = 0; j < 8; ++j) nx[j] = __builtin_nontemporal_load(xn + 64 * j); }
        f32x4 v[8]; float s = 0.f;
#pragma unroll
        for (int j = 0; j < 8; ++j) { const u32x2 hw = cur[j]; v[j] = (f32x4){bflo(hw.x), bfhi(hw.x), bflo(hw.y), bfhi(hw.y)}; s += (v[j].x * v[j].x + v[j].y * v[j].y) + (v[j].z * v[j].z + v[j].w * v[j].w); }
        const float rstd = rsqrtf(wave_sum(s) * (1.f / D) + EPS);
        f32x4* o = (f32x4*)(F.out + (size_t)m * D) + F.lane;
#pragma unroll
        for (int j = 0; j < 8; ++j) __builtin_nontemporal_store(v[j] * rstd * gg[j], o + 64 * j);
#pragma unroll
        for (int j = 0; j < 8; ++j) cur[j] = nx[j];
    }
}

__device__ __forceinline__ void bg_after(const Frame& F, const pg8::StaticOrder& S, int c, int kind, int lf, int kind2 = -1, int lf2 = 0, int kind3 = -1, int lf3 = 0) {
    if (kind < 0) return;
    const int rounds = (S.nwg + F.G - 1) / F.G, c0 = S.nwg - (rounds - 1) * F.G, nid = F.G - c0;
    const int rank = nid == 0 ? c : c - c0, nidle = nid == 0 ? F.G : nid;
    if (rank < 0) return;
    bg_convert(F, kind, lf, rank, nidle);
    if (kind2 >= 0) bg_convert(F, kind2, lf2, rank, nidle);
    if (kind3 >= 0) bg_convert(F, kind3, lf3, rank, nidle);
}
__device__ __forceinline__ void ph_gemm_bf16(const Frame& F, const pg8::Gemm g, const pg8::EpiBf16 E, int M_, int N_, int rot = 0, int bgkind = -1, int bglf = 0, int bgkind2 = -1, int bglf2 = 0, int bgkind3 = -1, int bglf3 = 0) {
    const int c = (int)((blockIdx.x + rot) % F.G);
    pg8::StaticOrder S; S.init(M_, N_, F.G, c); S.ntk = g.K / pg8::BK; if (N_ == DINP) S.wgm = 4; pg8::gemm_phase(F.lds, F.tid, g, S, E);
    bg_after(F, S, c, bgkind, bglf, bgkind2, bglf2, bgkind3, bglf3);
}
__device__ __forceinline__ void ph_gemm_resid(const Frame& F, const pg8::Gemm g, const pg8::EpiResid E, int ctx) {
    pg8::TailSplitOrder S; S.init(g.K, F.G, (int)blockIdx.x, ctx, 4); pg8::gemm_phase(F.lds, F.tid, g, S, E);
}
__device__ __forceinline__ void ph_gemm_swiglu(const Frame& F, const pg8::Gemm g, const pg8::EpiSwiGLU E, int M_, int N_, int bgkind = -1, int bglf = 0, int bgkind2 = -1, int bglf2 = 0) {
    const int c = (int)blockIdx.x;
    pg8::StaticOrder S; S.init(M_, N_, F.G, c); S.ntk = g.K / pg8::BK; pg8::gemm_phase(F.lds, F.tid, g, S, E);
    bg_after(F, S, c, bgkind, bglf, bgkind2, bglf2);
}

namespace fa {
typedef float f32x16 __attribute__((ext_vector_type(16)));
__device__ __forceinline__ float xhalf_max(float x) { const auto r = __builtin_amdgcn_permlane32_swap(__builtin_bit_cast(unsigned, x), __builtin_bit_cast(unsigned, x), false, false);
    return fmaxf(__builtin_bit_cast(float, (unsigned)r[0]), __builtin_bit_cast(float, (unsigned)r[1])); }
__device__ __forceinline__ float xhalf_sum(float x) { const auto r = __builtin_amdgcn_permlane32_swap(__builtin_bit_cast(unsigned, x), __builtin_bit_cast(unsigned, x), false, false);
    return __builtin_bit_cast(float, (unsigned)r[0]) + __builtin_bit_cast(float, (unsigned)r[1]); }
struct KeySrc {
    const bf16* Kb; int kpitch;
    const bf16* Vt; int vpitch;
    int row0, n0, row1, n1;
    int kpos1; int mask;
};
template <int DQK> struct Geo { static constexpr int KROW = DQK * 2 + 16, KBUF = 64 * KROW, VROW = 136, VBUF = 64 * VROW, BUF = KBUF + VBUF, KCH = DQK / 8, NKC = 64 * KCH; };

template <int DQK, int ROPE>
__device__ __forceinline__ void attn_unit(LAS unsigned char* lds, const int tid, const KeySrc& U, const bf16* qrow, const int tpos, const int qpos,
                                          const bool has_sink, const float sink_l2, const float scale_l2, bf16* orow) {
    typedef Geo<DQK> G;
    const int lane = tid & 63, h = lane >> 5, r = lane & 31;
    constexpr int NS = DQK / 16;
    bf16x8 qf[NS];
#pragma unroll
    for (int s = 0; s < NS; ++s) qf[s] = *(const bf16x8*)(qrow + 16 * s + 8 * h);
    if (ROPE == 1) {
#pragma unroll
        for (int s = 4; s < 6; ++s) {
            const u32x4 lo = *(const u32x4*)(qrow + 16 * s), hi = *(const u32x4*)(qrow + 16 * s + 8);
            const int pos = (s == 4) ? (tpos >> 6) : (tpos & 63);
            const f32x4 c0 = *(const f32x4*)(ROPE_COS_8 + pos * 8), c1 = *(const f32x4*)(ROPE_COS_8 + pos * 8 + 4), s0 = *(const f32x4*)(ROPE_SIN_8 + pos * 8), s1 = *(const f32x4*)(ROPE_SIN_8 + pos * 8 + 4);
            const float a[8] = {bflo(lo.x), bfhi(lo.x), bflo(lo.y), bfhi(lo.y), bflo(lo.z), bfhi(lo.z), bflo(lo.w), bfhi(lo.w)};
            const float b[8] = {bflo(hi.x), bfhi(hi.x), bflo(hi.y), bfhi(hi.y), bflo(hi.z), bfhi(hi.z), bflo(hi.w), bfhi(hi.w)};
            const float cs[8] = {c0.x, c0.y, c0.z, c0.w, c1.x, c1.y, c1.z, c1.w}, sn[8] = {s0.x, s0.y, s0.z, s0.w, s1.x, s1.y, s1.z, s1.w};
            float o[8];
#pragma unroll
            for (int i = 0; i < 8; ++i) o[i] = h ? (b[i] * cs[i] + a[i] * sn[i]) : (a[i] * cs[i] - b[i] * sn[i]);
            u32x4 w; w.x = pk2(o[0], o[1]); w.y = pk2(o[2], o[3]); w.z = pk2(o[4], o[5]); w.w = pk2(o[6], o[7]);
            qf[s] = __builtin_bit_cast(bf16x8, w);
        }
    }
    if (ROPE == 2) {
#pragma unroll
        for (int sp = 0; sp < 2; ++sp) {
            const int pos = sp ? (tpos & 63) : (tpos >> 6);
            const u32x4 lo = __builtin_bit_cast(u32x4, qf[2 * sp]), hi = __builtin_bit_cast(u32x4, qf[2 * sp + 1]);
            const f32x4 c0 = *(const f32x4*)(ROPE_COS_16 + pos * 16 + 8 * h), c1 = *(const f32x4*)(ROPE_COS_16 + pos * 16 + 8 * h + 4), s0 = *(const f32x4*)(ROPE_SIN_16 + pos * 16 + 8 * h), s1 = *(const f32x4*)(ROPE_SIN_16 + pos * 16 + 8 * h + 4);
            const float a[8] = {bflo(lo.x), bfhi(lo.x), bflo(lo.y), bfhi(lo.y), bflo(lo.z), bfhi(lo.z), bflo(lo.w), bfhi(lo.w)};
            const float b[8] = {bflo(hi.x), bfhi(hi.x), bflo(hi.y), bfhi(hi.y), bflo(hi.z), bfhi(hi.z), bflo(hi.w), bfhi(hi.w)};
            const float cs[8] = {c0.x, c0.y, c0.z, c0.w, c1.x, c1.y, c1.z, c1.w}, sn[8] = {s0.x, s0.y, s0.z, s0.w, s1.x, s1.y, s1.z, s1.w};
            float oa[8], ob[8];
#pragma unroll
            for (int i = 0; i < 8; ++i) { oa[i] = a[i] * cs[i] - b[i] * sn[i]; ob[i] = b[i] * cs[i] + a[i] * sn[i]; }
            u32x4 w; w.x = pk2(oa[0], oa[1]); w.y = pk2(oa[2], oa[3]); w.z = pk2(oa[4], oa[5]); w.w = pk2(oa[6], oa[7]); qf[2 * sp] = __builtin_bit_cast(bf16x8, w);
            w.x = pk2(ob[0], ob[1]); w.y = pk2(ob[2], ob[3]); w.z = pk2(ob[4], ob[5]); w.w = pk2(ob[6], ob[7]); qf[2 * sp + 1] = __builtin_bit_cast(bf16x8, w);
        }
    }
    f32x16 o0, o1;
#pragma unroll
    for (int i = 0; i < 16; ++i) { o0[i] = 0.f; o1[i] = 0.f; }
    float mrun = -INFINITY, lrun = 0.f;
    const int ntiles = U.n0 + U.n1;
    u32x4 kA0, kA1, vA, kB0, kB1, vB;
    const int kc0 = tid, kc1 = tid + 512;
    const int krow0 = kc0 / G::KCH, kpart0 = kc0 % G::KCH, krow1 = kc1 / G::KCH, kpart1 = kc1 % G::KCH;
    const int vd = tid >> 3, vpart = tid & 7;
#define FA_LOAD(j, K0, K1, V) do { const int _j = (j); const int R0 = _j < U.n0 ? U.row0 + 64 * _j : U.row1 + 64 * (_j - U.n0); \
        K0 = *(const u32x4*)(U.Kb + (size_t)(R0 + krow0) * U.kpitch + kpart0 * 8); \
        if (G::NKC > 512 && kc1 < G::NKC) K1 = *(const u32x4*)(U.Kb + (size_t)(R0 + krow1) * U.kpitch + kpart1 * 8); \
        V = *(const u32x4*)(U.Vt + (size_t)vd * U.vpitch + R0 + vpart * 8); } while (0)
#define FA_STORE(b, K0, K1, V) do { LAS unsigned char* _base = lds + (b) * G::BUF; \
        *(LAS u32x4*)(_base + krow0 * G::KROW + kpart0 * 16) = K0; \
        if (G::NKC > 512 && kc1 < G::NKC) *(LAS u32x4*)(_base + krow1 * G::KROW + kpart1 * 16) = K1; \
        *(LAS u32x2*)(_base + G::KBUF + vd * G::VROW + vpart * 16) = (u32x2){V.x, V.y}; *(LAS u32x2*)(_base + G::KBUF + vd * G::VROW + vpart * 16 + 8) = (u32x2){V.z, V.w}; } while (0)
#define FA_TILE(j) do { \
        const LAS unsigned char* cur = lds + ((j) & 1) * G::BUF; \
          \
        bf16x8 kf0[NS], kf1[NS]; \
        _Pragma("unroll") for (int s = 0; s < NS; ++s) { \
            kf0[s] = *(const LAS bf16x8*)(cur + r * G::KROW + (16 * s + 8 * h) * 2); \
            kf1[s] = *(const LAS bf16x8*)(cur + (32 + r) * G::KROW + (16 * s + 8 * h) * 2); } \
        asm volatile("s_waitcnt lgkmcnt(0)" ::: "memory"); __builtin_amdgcn_sched_barrier(0); \
        f32x16 s0 = __builtin_amdgcn_mfma_f32_32x32x16_bf16(kf0[0], qf[0], zero16, 0, 0, 0), s1 = __builtin_amdgcn_mfma_f32_32x32x16_bf16(kf1[0], qf[0], zero16, 0, 0, 0); \
        _Pragma("unroll") for (int s = 1; s < NS; ++s) { \
            s0 = __builtin_amdgcn_mfma_f32_32x32x16_bf16(kf0[s], qf[s], s0, 0, 0, 0); \
            s1 = __builtin_amdgcn_mfma_f32_32x32x16_bf16(kf1[s], qf[s], s1, 0, 0, 0); } \
          \
        const LAS unsigned char* vb = cur + G::KBUF; \
        u32x2 vl0[4], vh0[4], vl1[4], vh1[4]; \
        _Pragma("unroll") for (int ks = 0; ks < 4; ++ks) { \
            vl0[ks] = *(const LAS u32x2*)(vb + r * G::VROW + (16 * ks + 4 * h) * 2); vh0[ks] = *(const LAS u32x2*)(vb + r * G::VROW + (16 * ks + 8 + 4 * h) * 2); \
            vl1[ks] = *(const LAS u32x2*)(vb + (32 + r) * G::VROW + (16 * ks + 4 * h) * 2); vh1[ks] = *(const LAS u32x2*)(vb + (32 + r) * G::VROW + (16 * ks + 8 + 4 * h) * 2); } \
        __builtin_amdgcn_sched_barrier(0); \
        if (U.mask && (j) >= U.n0) { \
            const int kp0 = U.kpos1 + 64 * ((j) - U.n0) + 4 * h - qpos; \
            _Pragma("unroll") for (int i = 0; i < 16; ++i) { const int rel = kp0 + (i & 3) + 8 * (i >> 2); \
                if (rel > 128 || rel < -128) s0[i] = -INFINITY; \
                if (rel + 32 > 128 || rel + 32 < -128) s1[i] = -INFINITY; } } \
        float tmax = fmaxf(s0[0], s1[0]); \
        _Pragma("unroll") for (int i = 1; i < 16; ++i) tmax = fmaxf(tmax, fmaxf(s0[i], s1[i])); \
        tmax = xhalf_max(tmax) * scale_l2; \
        if (__any(tmax > mrun + 8.f)) {            \
            const float mnew = fmaxf(mrun, tmax); const float alpha = __builtin_amdgcn_exp2f(mrun - mnew); \
            lrun *= alpha; mrun = mnew; \
            _Pragma("unroll") for (int i = 0; i < 16; ++i) { o0[i] *= alpha; o1[i] *= alpha; } } \
        float rs = 0.f; \
        _Pragma("unroll") for (int i = 0; i < 16; ++i) { s0[i] = __builtin_amdgcn_exp2f(s0[i] * scale_l2 - mrun); s1[i] = __builtin_amdgcn_exp2f(s1[i] * scale_l2 - mrun); rs += s0[i] + s1[i]; } \
        lrun += rs; \
        bf16x8 pf[4]; \
        { u32x4 w; \
          w.x = pg8::cvt_pk_bf16(s0[0], s0[1]); w.y = pg8::cvt_pk_bf16(s0[2], s0[3]); w.z = pg8::cvt_pk_bf16(s0[4], s0[5]); w.w = pg8::cvt_pk_bf16(s0[6], s0[7]); pf[0] = __builtin_bit_cast(bf16x8, w); \
          w.x = pg8::cvt_pk_bf16(s0[8], s0[9]); w.y = pg8::cvt_pk_bf16(s0[10], s0[11]); w.z = pg8::cvt_pk_bf16(s0[12], s0[13]); w.w = pg8::cvt_pk_bf16(s0[14], s0[15]); pf[1] = __builtin_bit_cast(bf16x8, w); \
          w.x = pg8::cvt_pk_bf16(s1[0], s1[1]); w.y = pg8::cvt_pk_bf16(s1[2], s1[3]); w.z = pg8::cvt_pk_bf16(s1[4], s1[5]); w.w = pg8::cvt_pk_bf16(s1[6], s1[7]); pf[2] = __builtin_bit_cast(bf16x8, w); \
          w.x = pg8::cvt_pk_bf16(s1[8], s1[9]); w.y = pg8::cvt_pk_bf16(s1[10], s1[11]); w.z = pg8::cvt_pk_bf16(s1[12], s1[13]); w.w = pg8::cvt_pk_bf16(s1[14], s1[15]); pf[3] = __builtin_bit_cast(bf16x8, w); } \
        asm volatile("s_waitcnt lgkmcnt(0)" ::: "memory"); __builtin_amdgcn_sched_barrier(0); \
        _Pragma("unroll") for (int ks = 0; ks < 4; ++ks) { \
            const u32x4 f0 = {vl0[ks].x, vl0[ks].y, vh0[ks].x, vh0[ks].y}, f1 = {vl1[ks].x, vl1[ks].y, vh1[ks].x, vh1[ks].y}; \
            o0 = __builtin_amdgcn_mfma_f32_32x32x16_bf16(__builtin_bit_cast(bf16x8, f0), pf[ks], o0, 0, 0, 0); \
            o1 = __builtin_amdgcn_mfma_f32_32x32x16_bf16(__builtin_bit_cast(bf16x8, f1), pf[ks], o1, 0, 0, 0); } \
    } while (0)
    f32x16 zero16;
#pragma unroll
    for (int i = 0; i < 16; ++i) zero16[i] = 0.f;
    FA_LOAD(0, kA0, kA1, vA); if (ntiles > 1) FA_LOAD(1, kB0, kB1, vB);
    FA_STORE(0, kA0, kA1, vA); __syncthreads();
    for (int j = 0; j < ntiles; j += 2) {
        if (j + 2 < ntiles) FA_LOAD(j + 2, kA0, kA1, vA);
        FA_TILE(j);
        if (j + 1 < ntiles) FA_STORE(1, kB0, kB1, vB);
        __syncthreads();
        if (j + 1 < ntiles) {
            if (j + 3 < ntiles) FA_LOAD(j + 3, kB0, kB1, vB);
            FA_TILE(j + 1);
            if (j + 2 < ntiles) FA_STORE(0, kA0, kA1, vA);
            __syncthreads();
        }
    }
#undef FA_LOAD
#undef FA_STORE
#undef FA_TILE
    lrun = xhalf_sum(lrun);
    if (has_sink) lrun += __builtin_amdgcn_exp2f(sink_l2 - mrun);
    const float inv = 1.f / lrun;
#pragma unroll
    for (int g4 = 0; g4 < 4; ++g4) {
        u32x2 w0, w1;
        w0.x = pk2(o0[4 * g4] * inv, o0[4 * g4 + 1] * inv); w0.y = pk2(o0[4 * g4 + 2] * inv, o0[4 * g4 + 3] * inv);
        w1.x = pk2(o1[4 * g4] * inv, o1[4 * g4 + 1] * inv); w1.y = pk2(o1[4 * g4 + 2] * inv, o1[4 * g4 + 3] * inv);
        *(u32x2*)(orow + 8 * g4 + 4 * h) = w0; *(u32x2*)(orow + 32 + 8 * g4 + 4 * h) = w1;
    }
}
}

__device__ __forceinline__ void ph_attn(const Frame& F, int l) {
    const int tid = F.tid, w = F.wave, r = F.lane & 31;
    bf16* QM = ((bf16*)(F.ws + WS_QM)); bf16* KM = ((bf16*)(F.ws + WS_KM)); bf16* VT = ((bf16*)(F.ws + WS_VT));
    bf16* KS = ((bf16*)(F.ws + WS_KS)); bf16* VST = ((bf16*)(F.ws + WS_VST)); bf16* P = ((bf16*)(F.ws + WS_P));
    bf16* MX = ((bf16*)(F.ws + WS_MX)); bf16* SX = ((bf16*)(F.ws + WS_SX));
    const float sc_mla = 0.10206207261596575f * LOG2E, sc_swa = 0.125f * LOG2E;
    const int gsz = F.G >> 3, xg = F.vcu / gsz, nlist = l == DEPTH - 1 ? 128 : 136;
    unsigned* ctr = (unsigned*)(F.ws + WS_CTL) + 8192 + 512 * l + 64 * xg;
    volatile LAS unsigned* mail = (volatile LAS unsigned*)(F.lds + MISC_OFF + 64);
    unsigned ntick = 0;
    for (int li = F.vcu % gsz; li < nlist; ) {
        if (tid == 0) ntick = __hip_atomic_fetch_add(ctr, 1u, __ATOMIC_RELAXED, __HIP_MEMORY_SCOPE_AGENT) + (unsigned)gsz;
        const int u = li < 64 ? xg * 64 + li : li < 128 ? 512 + xg * 64 + (li - 64) : li < 132 ? 1024 + xg * 4 + (li - 128) : 1056 + xg * 4 + (li - 132);
        if (u < 512) {
            const int b = u >> 7, hh = (u >> 4) & 7, qb = u & 15;
            fa::KeySrc U{KM + hh * 96, 768, VT + (size_t)(hh * 64) * MT, MT, b * SEQ, 64, ML + b * CTX, 4, 0, 0};
            const int t = qb * 256 + 32 * w + r, row = b * SEQ + t;
            fa::attn_unit<96, 1>(F.lds, tid, U, QM + (size_t)row * 768 + hh * 96, t, 0, false, 0.f, sc_mla, MX + (size_t)row * 512 + hh * 64);
        } else if (u < 1024) {
            const int v = u - 512, b = v >> 7, g = (v >> 6) & 1, pb = v & 63;
            const int ks = pb * 64 - 128 < 0 ? 0 : pb * 64 - 128, ke = pb * 64 + 192 > SEQ ? SEQ : pb * 64 + 192;
            fa::KeySrc U{KS + g * 64, 128, VST + (size_t)(g * 64) * MT, MT, ML + b * CTX, 4, b * SEQ + ks, (ke - ks) >> 6, ks, 1};
            const int hq = 4 * g + (w >> 1), t = pb * 64 + 32 * (w & 1) + r, row = b * SEQ + t;
            fa::attn_unit<64, 2>(F.lds, tid, U, P + (size_t)row * DINP + PC_QS + hq * 64, t, t, true, INP(I_SINK)[l * 8 + hq] * LOG2E, sc_swa, SX + (size_t)row * 512 + hq * 64);
        } else if (u < 1056) {
            const int v = u - 1024, b = v >> 3, hh = v & 7;
            fa::KeySrc U{KM + hh * 96, 768, VT + (size_t)(hh * 64) * MT, MT, ML + b * CTX, 4, 0, 0, 0, 0};
            const int row = ML + b * CTX + 32 * w + r;
            fa::attn_unit<96, 0>(F.lds, tid, U, QM + (size_t)row * 768 + hh * 96, 0, 0, false, 0.f, sc_mla, MX + (size_t)row * 512 + hh * 64);
        } else {
            const int v = u - 1056, b = v >> 3, g = (v >> 2) & 1, hq = 4 * g + (v & 3);
            fa::KeySrc U{KS + g * 64, 128, VST + (size_t)(g * 64) * MT, MT, ML + b * CTX, 4, 0, 0, 0, 0};
            const int row = ML + b * CTX + 32 * w + r;
            fa::attn_unit<64, 0>(F.lds, tid, U, P + (size_t)row * DINP + PC_QS + hq * 64, 0, 0, true, INP(I_SINK)[l * 8 + hq] * LOG2E, sc_swa, SX + (size_t)row * 512 + hq * 64);
        }
        if (tid == 0) mail[0] = ntick;
        __syncthreads();
        li = (int)mail[0];
    }
}

__device__ __forceinline__ int chunk_row0(int c) { const int b = c / 34, cix = c % 34; return cix < 2 ? ML + b * CTX + 128 * cix : b * SEQ + 128 * (cix - 2); }
__device__ __forceinline__ bf16x8 ld_frag(const bf16* p) { return *(const bf16x8*)p; }
__device__ __forceinline__ f32x4 mfma16(bf16x8 a, bf16x8 b, f32x4 c) { return __builtin_amdgcn_mfma_f32_16x16x32_bf16(a, b, c, 0, 0, 0); }

__device__ __forceinline__ void ph_conv(const Frame& F, int l) {
    const int tid = F.tid;
    bf16* P = ((bf16*)(F.ws + WS_P)); bf16* XST = ((bf16*)(F.ws + WS_XS)); bf16* BT = ((bf16*)(F.ws + WS_BT)); bf16* BC = ((bf16*)(F.ws + WS_BC));
    const float* cw = INP(I_CONVW) + (size_t)l * 5 * 1536; const float* cbias = INP(I_CONVB) + (size_t)l * 1536;
    LAS unsigned char* tin = F.lds; LAS unsigned char* tout = F.lds + 36864;
    u32x4 rin[5];
#define CV_LOAD(u) do { const int c_ = (u) / 12, cb_ = (u) % 12, b_ = c_ / 34, cix_ = c_ % 34; \
        const int row0_ = chunk_row0(c_), lo_ = cix_ < 2 ? ML + b_ * CTX : b_ * SEQ, hi_ = cix_ < 2 ? lo_ + CTX : lo_ + SEQ; \
        _Pragma("unroll") for (int i = 0; i < 5; ++i) { const int idx = tid + 512 * i, ri = idx >> 4, part = idx & 15, grow = row0_ - 2 + ri; \
            rin[i] = (u32x4){0u, 0u, 0u, 0u}; \
            if (idx < 132 * 16 && grow >= lo_ && grow < hi_) rin[i] = *(const u32x4*)(P + (size_t)grow * DINP + PC_XBC + cb_ * 128 + part * 8); } } while (0)
#define CV_STORE() do { _Pragma("unroll") for (int i = 0; i < 5; ++i) { const int idx = tid + 512 * i, ri = idx >> 4, part = idx & 15; \
            if (idx < 132 * 16) *(LAS u32x4*)(tin + ri * 272 + part * 16) = rin[i]; } } while (0)
    int u = F.vcu;
    if (u < 136 * 12) { CV_LOAD(u); CV_STORE(); }
    __syncthreads();
    for (; u < 136 * 12; u += F.G) {
        const int c = u / 12, cb = u % 12, ch0 = cb * 128;
        const int row0 = chunk_row0(c);
        const int un = u + F.G;
        const float w0 = cw[ch0 + (tid & 127)], w1 = cw[1536 + ch0 + (tid & 127)], w2 = cw[2 * 1536 + ch0 + (tid & 127)], w3 = cw[3 * 1536 + ch0 + (tid & 127)], w4 = cw[4 * 1536 + ch0 + (tid & 127)], bs = cbias[ch0 + (tid & 127)];
        if (un < 136 * 12) CV_LOAD(un);
        {
            const int ch = tid & 127, q = tid >> 7, t0 = 32 * q;
            const LAS bf16* col = (const LAS bf16*)tin + ch;
            float x0 = bf2f(col[(t0 + 0) * 136]), x1 = bf2f(col[(t0 + 1) * 136]), x2 = bf2f(col[(t0 + 2) * 136]), x3 = bf2f(col[(t0 + 3) * 136]);
#pragma unroll 4
            for (int tp = 0; tp < 16; ++tp) {
                const int t = t0 + 2 * tp;
                const float x4 = bf2f(col[(t + 4) * 136]), x5 = bf2f(col[(t + 5) * 136]);
                const float y0 = pg8::silu_fast(bs + w0 * x0 + w1 * x1 + w2 * x2 + w3 * x3 + w4 * x4), y1 = pg8::silu_fast(bs + w0 * x1 + w1 * x2 + w2 * x3 + w3 * x4 + w4 * x5);
                if (cb < 10) *(LAS unsigned*)(tout + ch * 264 + t * 2) = pk2(y0, y1);
                if (cb >= 8) { BC[(size_t)(row0 + t) * 512 + (cb - 8) * 128 + ch] = (bf16)f2bf(y0); BC[(size_t)(row0 + t + 1) * 512 + (cb - 8) * 128 + ch] = (bf16)f2bf(y1); }
                x0 = x2; x1 = x3; x2 = x4; x3 = x5;
            }
        }
        __syncthreads();
        if (cb < 10) {
            bf16* dst = cb < 8 ? XST + ((size_t)c * 1024 + ch0) * 128 : BT + ((size_t)c * 256 + (cb - 8) * 128) * 128;
            for (int idx = tid; idx < 128 * 32; idx += 512) { const int chl = idx >> 5, part = idx & 31;
                *(u32x2*)(dst + (size_t)chl * 128 + part * 4) = *(const LAS u32x2*)(tout + chl * 264 + part * 8); }
        }
        if (un < 136 * 12) CV_STORE();
        __syncthreads();
    }
#undef CV_LOAD
#undef CV_STORE
}

__device__ __forceinline__ void ph_dtcum(const Frame& F, int l) {
    const int gw = F.vcu * NWAVES + F.wave, NGW = F.G * NWAVES, lane = F.lane;
    bf16* P = ((bf16*)(F.ws + WS_P)); float* CUM = ((float*)(F.ws + WS_CUM)); float* DEC = ((float*)(F.ws + WS_DEC)); float* WL = ((float*)(F.ws + WS_DT));
    for (int it = gw; it < 136 * 32; it += NGW) {
        const int d = it & 1, h = (it >> 1) & 15, c = it >> 5, row0 = chunk_row0(c);
        const float A = -__expf(INP(I_ALOG)[l * 32 + d * 16 + h]), bias = INP(I_DTB)[l * 32 + d * 16 + h];
        const float v0 = bf2f(P[(size_t)(row0 + 2 * lane) * DINP + PC_DT + d * 16 + h]) + bias, v1 = bf2f(P[(size_t)(row0 + 2 * lane + 1) * DINP + PC_DT + d * 16 + h]) + bias;
        const float dt0 = v0 > 20.f ? v0 : log1pf(__expf(v0)), dt1 = v1 > 20.f ? v1 : log1pf(__expf(v1));
        const float a0 = dt0 * A, a1 = dt1 * A;
        float incl = a0 + a1;
#pragma unroll
        for (int o = 1; o < 64; o <<= 1) { const float t = __shfl_up(incl, o); if (lane >= o) incl += t; }
        const float T = __shfl(incl, 63);
        float c0, c1;
        if (d == 0) { c1 = incl; c0 = incl - a1; } else { c0 = T - incl + a0 + a1; c1 = T - incl + a1; }
        const size_t u = (size_t)c * 16 + h;
        *(f32x2*)(WL + u * 256 + d * 128 + 2 * lane) = (f32x2){dt0 * __expf(T - c0), dt1 * __expf(T - c1)};
        *(f32x2*)(CUM + u * 512 + d * 128 + 2 * lane) = (f32x2){c0, c1}; *(f32x2*)(CUM + u * 512 + 256 + d * 128 + 2 * lane) = (f32x2){dt0, dt1};
        if (lane == 0) DEC[(c * 2 + d) * 16 + h] = __expf(T);
    }
}
__device__ __forceinline__ void ph_ssd_a(const Frame& F, int l) {
    const int tid = F.tid, lane = F.lane, w = F.wave, fr = lane & 15, fq = lane >> 4;
    bf16* XST = ((bf16*)(F.ws + WS_XS)); bf16* BT = ((bf16*)(F.ws + WS_BT)); bf16* BC = ((bf16*)(F.ws + WS_BC)); bf16* CBb = ((bf16*)(F.ws + WS_CB)); bf16* ST = ((bf16*)(F.ws + WS_ST));
    const float* WL = ((float*)(F.ws + WS_DT));
    constexpr int SETB = 53248;
    const int NU = 136 * 16;
    u32x4 rx[2], rb[4];
#define SA_LOAD(u) do { const int c_ = (u) >> 4, h_ = (u) & 15, g_ = h_ >> 3; \
        _Pragma("unroll") for (int i = 0; i < 2; ++i) { const int idx = tid + 512 * i; rx[i] = *(const u32x4*)(XST + ((size_t)(c_ * 16 + h_) * 64 + (idx >> 4)) * 128 + (idx & 15) * 8); } \
        _Pragma("unroll") for (int i = 0; i < 4; ++i) { const int idx = tid + 512 * i; rb[i] = *(const u32x4*)(BT + ((size_t)(c_ * 2 + g_) * 128 + (idx >> 4)) * 128 + (idx & 15) * 8); } } while (0)
#define SA_STORE(base) do { \
        _Pragma("unroll") for (int i = 0; i < 2; ++i) { const int idx = tid + 512 * i; *(LAS u32x4*)((base) + (idx >> 4) * 272 + (idx & 15) * 16) = rx[i]; } \
        _Pragma("unroll") for (int i = 0; i < 4; ++i) { const int idx = tid + 512 * i; *(LAS u32x4*)((base) + 17408 + (idx >> 4) * 272 + (idx & 15) * 16) = rb[i]; } } while (0)
    int u = F.vcu, cur = 0;
    if (u < NU) { SA_LOAD(u); SA_STORE(F.lds); }
    __syncthreads();
    for (; u < NU; u += F.G, cur ^= 1) {
        const int un = u + F.G;
        const float* wl = WL + (size_t)u * 256 + 8 * fq;
        f32x4 wa[4][2], wb[4][2];
#pragma unroll
        for (int kk = 0; kk < 4; ++kk) { wa[kk][0] = *(const f32x4*)(wl + 32 * kk); wa[kk][1] = *(const f32x4*)(wl + 32 * kk + 4); wb[kk][0] = *(const f32x4*)(wl + 128 + 32 * kk); wb[kk][1] = *(const f32x4*)(wl + 128 + 32 * kk + 4); }
        if (un < NU) SA_LOAD(un);
        const LAS unsigned char* lx = F.lds + cur * SETB; const LAS unsigned char* lb = lx + 17408;
        const int c = u >> 4, h = u & 15;
        bf16x8 afa[4], afb[4];
#pragma unroll
        for (int kk = 0; kk < 4; ++kk) {
            const u32x4 bw = *(const LAS u32x4*)(lb + (16 * w + fr) * 272 + 16 * fq + 64 * kk);
            const float x[8] = {bflo(bw.x), bfhi(bw.x), bflo(bw.y), bfhi(bw.y), bflo(bw.z), bfhi(bw.z), bflo(bw.w), bfhi(bw.w)};
            const f32x4 wa0 = wa[kk][0], wa1 = wa[kk][1], wb0 = wb[kk][0], wb1 = wb[kk][1];
            u32x4 xa, xb;
            xa.x = pk2(x[0] * wa0.x, x[1] * wa0.y); xa.y = pk2(x[2] * wa0.z, x[3] * wa0.w); xa.z = pk2(x[4] * wa1.x, x[5] * wa1.y); xa.w = pk2(x[6] * wa1.z, x[7] * wa1.w);
            xb.x = pk2(x[0] * wb0.x, x[1] * wb0.y); xb.y = pk2(x[2] * wb0.z, x[3] * wb0.w); xb.z = pk2(x[4] * wb1.x, x[5] * wb1.y); xb.w = pk2(x[6] * wb1.z, x[7] * wb1.w);
            afa[kk] = __builtin_bit_cast(bf16x8, xa); afb[kk] = __builtin_bit_cast(bf16x8, xb);
        }
#pragma unroll
        for (int jp = 0; jp < 4; ++jp) {
            f32x4 acc0 = {0.f, 0.f, 0.f, 0.f}, acc1 = acc0;
            bf16x8 xf[4];
#pragma unroll
            for (int kk = 0; kk < 4; ++kk) xf[kk] = *(const LAS bf16x8*)(lx + (16 * jp + fr) * 272 + 16 * fq + 64 * kk);
#pragma unroll
            for (int kk = 0; kk < 4; ++kk) {
                acc0 = mfma16(afa[kk], xf[kk], acc0);
                acc1 = mfma16(afb[kk], xf[kk], acc1);
            }
            const int p = 16 * jp + fr, n = 16 * w + 4 * fq;
            u32x2 o0, o1; o0.x = pk2(acc0[0], acc0[1]); o0.y = pk2(acc0[2], acc0[3]); o1.x = pk2(acc1[0], acc1[1]); o1.y = pk2(acc1[2], acc1[3]);
            *(u32x2*)(ST + ((size_t)((c * 2 + 0) * 16 + h) * 64 + p) * 128 + n) = o0;
            *(u32x2*)(ST + ((size_t)((c * 2 + 1) * 16 + h) * 64 + p) * 128 + n) = o1;
        }
        if (un < NU) SA_STORE(F.lds + (cur ^ 1) * SETB);
        __syncthreads();
    }
#undef SA_LOAD
#undef SA_STORE
    for (int v = F.vcu; v < 136 * 2; v += F.G) {
        const int c = v >> 1, g = v & 1, row0 = chunk_row0(c);
        bf16x8 af[4];
        const bf16* bp = BC + (size_t)(row0 + 16 * w + fr) * 512 + g * 128 + 8 * fq;
#pragma unroll
        for (int kk = 0; kk < 4; ++kk) af[kk] = ld_frag(bp + 32 * kk);
#pragma unroll
        for (int jh = 0; jh < 8; jh += 4) {
            bf16x8 cf[4][4];
#pragma unroll
            for (int jx = 0; jx < 4; ++jx) { const bf16* cp = BC + (size_t)(row0 + 16 * (jh + jx) + fr) * 512 + 256 + g * 128 + 8 * fq;
#pragma unroll
                for (int kk = 0; kk < 4; ++kk) cf[jx][kk] = ld_frag(cp + 32 * kk); }
#pragma unroll
            for (int jx = 0; jx < 4; ++jx) { const int jl = jh + jx;
                f32x4 acc = {0.f, 0.f, 0.f, 0.f};
#pragma unroll
                for (int kk = 0; kk < 4; ++kk) acc = mfma16(af[kk], cf[jx][kk], acc);
                const int li = 16 * jl + fr, s = 16 * w + 4 * fq;
                u32x2 o; o.x = pk2(acc[0], acc[1]); o.y = pk2(acc[2], acc[3]);
                *(u32x2*)(CBb + ((size_t)(c * 2 + g) * 128 + li) * 128 + s) = o; }
        }
    }
}

__device__ __forceinline__ void ph_ssd_scan(const Frame& F) {
    const size_t gtid = (size_t)F.vcu * 512 + F.tid, gth = (size_t)F.G * 512;
    bf16* ST = ((bf16*)(F.ws + WS_ST)); const float* DEC = ((float*)(F.ws + WS_DEC));
    for (size_t idx = gtid; idx < 131072; idx += gth) {
        const int nch = idx & 15, p = (idx >> 4) & 63, h = (idx >> 10) & 15, d = (idx >> 14) & 1, b = (int)(idx >> 15);
        float hr[8]; float zz = 0.f; asm volatile("" : "+v"(zz));
#pragma unroll
        for (int j = 0; j < 8; ++j) hr[j] = zz;
#define SCN_C(step) (b * 34 + (d == 0 ? (step) : ((step) < 2 ? 1 - (step) : 35 - (step))))
#define SCN_PTR(c) ((u32x4*)(ST + ((size_t)(((c) * 2 + d) * 16 + h) * 64 + p) * 128 + nch * 8))
#pragma unroll 1
        for (int half = 0; half < 2; ++half) {
            u32x4 sv[17]; float dc[17];
#pragma unroll
            for (int s = 0; s < 17; ++s) { const int c = SCN_C(half * 17 + s); dc[s] = DEC[(c * 2 + d) * 16 + h]; }
#pragma unroll
            for (int s = 0; s < 17; ++s) { const int c = SCN_C(half * 17 + s); sv[s] = *SCN_PTR(c); }
#pragma unroll
            for (int s = 0; s < 17; ++s) {
                const int c = SCN_C(half * 17 + s); const float dec = dc[s];
                u32x4 o; o.x = pk2(hr[0], hr[1]); o.y = pk2(hr[2], hr[3]); o.z = pk2(hr[4], hr[5]); o.w = pk2(hr[6], hr[7]);
                *SCN_PTR(c) = o;
                hr[0] = dec * hr[0] + bflo(sv[s].x); hr[1] = dec * hr[1] + bfhi(sv[s].x); hr[2] = dec * hr[2] + bflo(sv[s].y); hr[3] = dec * hr[3] + bfhi(sv[s].y);
                hr[4] = dec * hr[4] + bflo(sv[s].z); hr[5] = dec * hr[5] + bfhi(sv[s].z); hr[6] = dec * hr[6] + bflo(sv[s].w); hr[7] = dec * hr[7] + bfhi(sv[s].w);
            }
        }
#undef SCN_C
#undef SCN_PTR
    }
}

__device__ __forceinline__ void ph_ssd_c(const Frame& F, int l) {
    const int tid = F.tid, lane = F.lane, w = F.wave, fr = lane & 15, fq = lane >> 4;
    bf16* XST = ((bf16*)(F.ws + WS_XS)); bf16* BC = ((bf16*)(F.ws + WS_BC)); bf16* CBb = ((bf16*)(F.ws + WS_CB)); bf16* ST = ((bf16*)(F.ws + WS_ST)); bf16* P = ((bf16*)(F.ws + WS_P));
    const float* CUM = ((float*)(F.ws + WS_CUM)); bf16* YG = ((bf16*)(F.ws + WS_YG)); float* SSQ = ((float*)(F.ws + WS_SSQ));
    constexpr int SETB = 55296;
    const int NU = 136 * 16;
    const bool lastl = (l == DEPTH - 1);
#define SC_VALID(u) (!(lastl && (((u) >> 4) % 34) < 2))
#define SC_LOAD(u) do { const int c_ = (u) >> 4, h_ = (u) & 15; \
        _Pragma("unroll") for (int i = 0; i < 2; ++i) { const int idx = tid + 512 * i, rr = idx >> 4, part = idx & 15; \
            rx[i] = __builtin_nontemporal_load((const u32x4*)(XST + ((size_t)(c_ * 16 + h_) * 64 + rr) * 128 + part * 8)); \
            rf[i] = __builtin_nontemporal_load((const u32x4*)(ST + ((size_t)((c_ * 2 + 0) * 16 + h_) * 64 + rr) * 128 + part * 8)); \
            rb[i] = __builtin_nontemporal_load((const u32x4*)(ST + ((size_t)((c_ * 2 + 1) * 16 + h_) * 64 + rr) * 128 + part * 8)); } \
        if (tid < 128) rc = *(const f32x4*)(CUM + (size_t)(u) * 512 + 4 * tid); \
        { const int g_ = h_ >> 3, r0_ = chunk_row0(c_), li_ = 16 * w + fr; \
          _Pragma("unroll") for (int kk = 0; kk < 4; ++kk) { ncb[kk] = *(const u32x4*)(CBb + ((size_t)(c_ * 2 + g_) * 128 + li_) * 128 + 32 * kk + 8 * fq); \
              ncv[kk] = *(const u32x4*)(BC + (size_t)(r0_ + li_) * 512 + 256 + g_ * 128 + 32 * kk + 8 * fq); } \
          _Pragma("unroll") for (int jp = 0; jp < 4; ++jp) nz[jp] = *(const u32x2*)(P + (size_t)(r0_ + li_) * DINP + PC_Z + h_ * 64 + 16 * jp + 4 * fq); } } while (0)
#define SC_STORE(base) do { \
        _Pragma("unroll") for (int i = 0; i < 2; ++i) { const int idx = tid + 512 * i, rr = idx >> 4, part = idx & 15; \
            *(LAS u32x4*)((base) + rr * 272 + part * 16) = rx[i]; *(LAS u32x4*)((base) + 17408 + rr * 272 + part * 16) = rf[i]; *(LAS u32x4*)((base) + 34816 + rr * 272 + part * 16) = rb[i]; } \
        if (tid < 128) *(LAS f32x4*)((base) + 52224 + 16 * tid) = rc; } while (0)
    u32x4 rx[2], rf[2], rb[2]; f32x4 rc; u32x4 ncb[4], ncv[4], ccb[4], ccv[4]; u32x2 nz[4], cz[4];
    int u = F.vcu; while (u < NU && !SC_VALID(u)) u += F.G;
    int cur = 0;
    if (u < NU) { SC_LOAD(u); SC_STORE(F.lds); }
    __syncthreads();
    while (u < NU) {
        int un = u + F.G; while (un < NU && !SC_VALID(un)) un += F.G;
#pragma unroll
        for (int kk = 0; kk < 4; ++kk) { ccb[kk] = ncb[kk]; ccv[kk] = ncv[kk]; cz[kk] = nz[kk]; }
        if (un < NU) SC_LOAD(un);
        LAS unsigned char* lx = F.lds + cur * SETB; LAS unsigned char* lhf = lx + 17408; LAS unsigned char* lhb = lx + 34816; LAS float* lc = (LAS float*)(lx + 52224);
        const int c = u >> 4, h = u & 15, g = h >> 3, row0 = chunk_row0(c);
        const float dskip = INP(I_DSKIP)[l * 16 + h];
        int li = 16 * w + fr;
        asm volatile("" : "+v"(li));
        const float cfl = lc[li], cbl = lc[128 + li];
        const float ef = __expf(cfl), eb = __expf(cbl);
        bf16x8 mf[4];
#pragma unroll
        for (int kk = 0; kk < 4; ++kk) {
            const int s0 = 32 * kk + 8 * fq;
            const u32x4 cw4 = ccb[kk];
            const float cbv[8] = {bflo(cw4.x), bfhi(cw4.x), bflo(cw4.y), bfhi(cw4.y), bflo(cw4.z), bfhi(cw4.z), bflo(cw4.w), bfhi(cw4.w)};
            float m[8];
            const int dk = w >> 1;
            if (kk < dk) {
                const f32x4 cfs0 = *(const LAS f32x4*)(lc + s0), cfs1 = *(const LAS f32x4*)(lc + s0 + 4), dtf0 = *(const LAS f32x4*)(lc + 256 + s0), dtf1 = *(const LAS f32x4*)(lc + 256 + s0 + 4);
                const float cfs[8] = {cfs0.x, cfs0.y, cfs0.z, cfs0.w, cfs1.x, cfs1.y, cfs1.z, cfs1.w}, dtf[8] = {dtf0.x, dtf0.y, dtf0.z, dtf0.w, dtf1.x, dtf1.y, dtf1.z, dtf1.w};
#pragma unroll
                for (int j = 0; j < 8; ++j) m[j] = cbv[j] * (__expf(cfl - cfs[j]) * dtf[j]);
            } else if (kk > dk) {
                const f32x4 cbs0 = *(const LAS f32x4*)(lc + 128 + s0), cbs1 = *(const LAS f32x4*)(lc + 128 + s0 + 4), dtb0 = *(const LAS f32x4*)(lc + 384 + s0), dtb1 = *(const LAS f32x4*)(lc + 384 + s0 + 4);
                const float cbs[8] = {cbs0.x, cbs0.y, cbs0.z, cbs0.w, cbs1.x, cbs1.y, cbs1.z, cbs1.w}, dtb[8] = {dtb0.x, dtb0.y, dtb0.z, dtb0.w, dtb1.x, dtb1.y, dtb1.z, dtb1.w};
#pragma unroll
                for (int j = 0; j < 8; ++j) m[j] = cbv[j] * (__expf(cbl - cbs[j]) * dtb[j]);
            } else {
                const f32x4 cfs0 = *(const LAS f32x4*)(lc + s0), cfs1 = *(const LAS f32x4*)(lc + s0 + 4);
                const f32x4 cbs0 = *(const LAS f32x4*)(lc + 128 + s0), cbs1 = *(const LAS f32x4*)(lc + 128 + s0 + 4);
                const f32x4 dtf0 = *(const LAS f32x4*)(lc + 256 + s0), dtf1 = *(const LAS f32x4*)(lc + 256 + s0 + 4);
                const f32x4 dtb0 = *(const LAS f32x4*)(lc + 384 + s0), dtb1 = *(const LAS f32x4*)(lc + 384 + s0 + 4);
                const float cfs[8] = {cfs0.x, cfs0.y, cfs0.z, cfs0.w, cfs1.x, cfs1.y, cfs1.z, cfs1.w}, cbs[8] = {cbs0.x, cbs0.y, cbs0.z, cbs0.w, cbs1.x, cbs1.y, cbs1.z, cbs1.w};
                const float dtf[8] = {dtf0.x, dtf0.y, dtf0.z, dtf0.w, dtf1.x, dtf1.y, dtf1.z, dtf1.w}, dtb[8] = {dtb0.x, dtb0.y, dtb0.z, dtb0.w, dtb1.x, dtb1.y, dtb1.z, dtb1.w};
#pragma unroll
                for (int j = 0; j < 8; ++j) { const int s = s0 + j;
                    const float wf = s <= li ? __expf(cfl - cfs[j]) * dtf[j] : 0.f, wb = s >= li ? __expf(cbl - cbs[j]) * dtb[j] : 0.f;
                    m[j] = cbv[j] * (wf + wb) + (s == li ? dskip : 0.f); }
            }
            u32x4 mw; mw.x = pk2(m[0], m[1]); mw.y = pk2(m[2], m[3]); mw.z = pk2(m[4], m[5]); mw.w = pk2(m[6], m[7]); mf[kk] = __builtin_bit_cast(bf16x8, mw);
        }
        float ssq = 0.f;
        const size_t grow = (size_t)(row0 + li);
#pragma unroll
        for (int jp = 0; jp < 4; ++jp) {
            const int ro = (16 * jp + fr) * 272 + 16 * fq;
            bf16x8 ax[4], af_[4], ab_[4];
#pragma unroll
            for (int kk = 0; kk < 4; ++kk) { ax[kk] = *(const LAS bf16x8*)(lx + ro + 64 * kk); af_[kk] = *(const LAS bf16x8*)(lhf + ro + 64 * kk); ab_[kk] = *(const LAS bf16x8*)(lhb + ro + 64 * kk); }
            f32x4 acc = {0.f, 0.f, 0.f, 0.f}, acc1 = acc, acc2 = acc;
#pragma unroll
            for (int kk = 0; kk < 4; ++kk) {
                acc = mfma16(ax[kk], mf[kk], acc);
                acc1 = mfma16(af_[kk], __builtin_bit_cast(bf16x8, ccv[kk]), acc1);
                acc2 = mfma16(ab_[kk], __builtin_bit_cast(bf16x8, ccv[kk]), acc2);
            }
            acc = acc + acc1 * ef + acc2 * eb;
            const int p = 16 * jp + 4 * fq;
            const u32x2 zw = cz[jp];
            const float y0 = acc[0] * pg8::silu_fast(bflo(zw.x)), y1 = acc[1] * pg8::silu_fast(bfhi(zw.x)), y2 = acc[2] * pg8::silu_fast(bflo(zw.y)), y3 = acc[3] * pg8::silu_fast(bfhi(zw.y));
            ssq += (y0 * y0 + y1 * y1) + (y2 * y2 + y3 * y3);
            u32x2 o; o.x = pk2(y0, y1); o.y = pk2(y2, y3);
            *(u32x2*)(YG + grow * 1024 + h * 64 + p) = o;
        }
        ssq += __shfl_xor(ssq, 16); ssq += __shfl_xor(ssq, 32);
        if (fq == 0) SSQ[grow * 16 + h] = ssq;
        if (un < NU) SC_STORE(F.lds + (cur ^ 1) * SETB);
        __syncthreads();
        u = un; cur ^= 1;
    }
#undef SC_VALID
#undef SC_LOAD
#undef SC_STORE
}

struct KArgs { const float* in[26]; float* out; unsigned char* ws; int lo, hi; };
constexpr int N_STEPS = 2 + 8 * 3 + 4 * 8 + 1;

__global__ void __launch_bounds__(NWAVES * 64, 2) mk_fwd(KArgs args) {
    extern __shared__ __attribute__((aligned(16))) unsigned char lds_raw[];
    Frame F0;
    F0.lds = (LAS unsigned char*)lds_raw;
    F0.tid = threadIdx.x; F0.lane = F0.tid & 63; F0.wave = __builtin_amdgcn_readfirstlane(F0.tid >> 6);
    F0.G = gridDim.x; { const int bx = blockIdx.x; F0.vcu = (F0.G % 8 == 0) ? (bx % 8) * (F0.G / 8) + bx / 8 : bx; }
    F0.out = args.out; F0.ws = args.ws;
    for (int u = F0.tid; u < (LDS_BYTES - LDSCTL_OFF) / 4; u += NWAVES * 64) ((LAS unsigned*)(F0.lds + LDSCTL_OFF))[u] = 0u;
    __syncthreads();
    if (F0.tid < 26) *(LAS unsigned long long*)(F0.lds + PTAB_OFF + 8 * F0.tid) = (unsigned long long)args.in[F0.tid];
    __syncthreads();
    volatile LAS unsigned* MISC = (volatile LAS unsigned*)(F0.lds + MISC_OFF);
    XcdBarrier bar; bar.bar = ((unsigned*)(F0.ws + WS_CTL)) + CW_BAR; bar.x = 0; bar.st = nullptr;
#if ONE_LAUNCH
    bar = xcd_barrier_post(((unsigned*)(F0.ws + WS_CTL)) + CW_BAR, MISC + 8);
#endif
    const int lo = args.lo, hi = args.hi;
    int step = 0;
#ifndef ONLY
#define ONLY (-1)
#endif
#define SEL(id) (ONLY < 0 || ONLY == (id))
#ifndef PROBE_SET
#define PROBE_SET 0
#endif
#ifndef PROBE_BAR
#define PROBE_BAR 0
#endif
#ifndef PROBE_SUB
#define PROBE_SUB 0
#endif
#define SUBREP(b) (1 + ((PROBE_SUB >> (b)) & 1))
#define NREP(id) (1 + ((PROBE_SET >> (id)) & 1))
#if ONE_LAUNCH
#define STEP(id, ...) do { if (SEL(id) && step >= lo && step < hi) { for (int rep = 0; rep < NREP(id); ++rep) { const Frame F = fresh(F0); __VA_ARGS__; } if (step + 1 < hi) { XcdBarrier b2 = bar; asm volatile("" : "+s"(b2.bar)); xcd_barrier(b2); if (PROBE_BAR) xcd_barrier(b2); } } ++step; } while (0)
#else
#define STEP(id, ...) do { if (SEL(id) && step >= lo && step < hi) { for (int rep = 0; rep < NREP(id); ++rep) { const Frame F = fresh(F0); __VA_ARGS__; } } ++step; } while (0)
#endif
    STEP(0, ph_prologue(F));
    STEP(1, ph_modfinal(F));
    for (int i = 0; i < 8; ++i) {
        const int l = i >> 1, f = i & 1;

        if (f == 1) {

            STEP(2, ph_norm(F, l, 1, l, rep ? -1 : 2, 0.5f, MT));
            STEP(3, ph_gemm_bf16(F, pg8::Gemm{((bf16*)(F.ws + WS_U)), ((bf16*)(F.ws + WS_WIN)) + (size_t)l * DINP * D, D, D, D}, pg8::EpiBf16{((bf16*)(F.ws + WS_P)), DINP, nullptr, nullptr, 0}, MT, DINP, 0, (rep == 0) ? 0 : -1, l < DEPTH - 1 ? 2 * l + 2 : 7, (l < DEPTH - 1 && rep == 0) ? 2 : -1, l + 1, (l == 0 && rep == 0) ? 4 : -1, 1));
            STEP(4, { for (int q = 0; q < SUBREP(0); ++q) ph_conv(F, l); for (int q = 0; q < SUBREP(1); ++q) ph_prep(F, l); ph_dtcum(F, l); });
            STEP(5, { { const bf16* Pp = ((bf16*)(F.ws + WS_P)); const float* rstd = ((float*)(F.ws + WS_RSTD)); ph_gemm_bf16(F, pg8::Gemm{Pp + PC_CQ, ((bf16*)(F.ws + WS_WUQ)) + (size_t)l * 768 * 384, DINP, 384, 384}, pg8::EpiBf16{((bf16*)(F.ws + WS_QM)), 768, rstd, nullptr, 0}, MT, 768);
                      ph_gemm_bf16(F, pg8::Gemm{Pp + PC_CKV, ((bf16*)(F.ws + WS_WUK)) + (size_t)l * 512 * 256, DINP, 256, 256}, pg8::EpiBf16{((bf16*)(F.ws + WS_KM)), 768, rstd + MT, nullptr, 1}, MT, 512, 52);
                      ph_gemm_bf16(F, pg8::Gemm{((bf16*)(F.ws + WS_WUV)) + (size_t)l * 512 * 256, Pp + PC_CKV, 256, DINP, 256}, pg8::EpiBf16{((bf16*)(F.ws + WS_VT)), MT, nullptr, rstd + MT, 0}, 512, MT, 172);
                      } for (int q = 0; q < SUBREP(3); ++q) ph_ssd_a(F, l); });
            STEP(6, { if (rep == 0) ph_ssd_scan(F); ph_attn(F, l); });
            STEP(13, { for (int q = 0; q < SUBREP(4); ++q) ph_ssd_c(F, l); });
            STEP(7, { for (int q = 0; q < SUBREP(5); ++q) ph_outnorm(F, l); });
            STEP(8, ph_gemm_resid(F, pg8::Gemm{((bf16*)(F.ws + WS_OX)), ((bf16*)(F.ws + WS_WOUT)) + (size_t)l * D * D, D, D, D}, pg8::EpiResid{((bf16*)(F.ws + WS_H)), ((float*)(F.ws + WS_MODV)) + (size_t)l * 5 * NMODV, 5, rep ? 0.0f : 1.0f, D / 64, ((bf16*)(F.ws + WS_PART))}, l != DEPTH - 1));
        }
        STEP(9, ph_norm(F, l, f ? 2 : 0, f ? l : l - 1, rep ? -1 : (f ? 5 : (l > 0 ? 8 : -1)), f ? 1.0f : 0.5f, (l == DEPTH - 1 && f) ? ML : MT));
        STEP(10, ph_gemm_swiglu(F, pg8::Gemm{((bf16*)(F.ws + WS_U)), ((bf16*)(F.ws + WS_WGU)) + (size_t)i * 11264 * D, D, D, D}, pg8::EpiSwiGLU{((bf16*)(F.ws + WS_HID)), DFF}, (l == DEPTH - 1 && f) ? ML : MT, 11264, (i < 7 && rep == 0) ? 1 : -1, i + 1, (i <= 4 && rep == 0) ? ((i & 1) || i == 0 ? 3 : 4) : -1, i == 0 ? 1 : i <= 2 ? 3 : 5));
        STEP(11, ph_gemm_resid(F, pg8::Gemm{((bf16*)(F.ws + WS_HID)), ((bf16*)(F.ws + WS_WD)) + (size_t)i * D * DFF, DFF, DFF, DFF}, pg8::EpiResid{((bf16*)(F.ws + WS_H)), ((float*)(F.ws + WS_MODV)) + (size_t)l * 5 * NMODV, f ? 8 : 2, rep ? 0.0f : 0.5f, DFF / 64, ((bf16*)(F.ws + WS_PART))}, !(l == DEPTH - 1 && f)));
    }
    STEP(12, ph_final(F));
#undef STEP
}

extern "C" void kernel_launch(void* const* d_in, const int* in_sizes, int n_in, void* d_out, int out_size, void* d_ws, size_t ws_size, hipStream_t stream) {
    static int grid = 0;
    if (grid == 0) {
        if (n_in != 26 || out_size != ML * D || ws_size < WS_END) { fprintf(stderr, "kernel_launch: unexpected shapes (n_in %d out %d ws %zu)\n", n_in, out_size, ws_size); grid = -1; return; }
        int dev = 0, cus = 0, per_cu = 0;
        if (hipGetDevice(&dev) != hipSuccess || hipDeviceGetAttribute(&cus, hipDeviceAttributeMultiprocessorCount, dev) != hipSuccess) { grid = -1; return; }
        if (hipFuncSetAttribute((const void*)mk_fwd, hipFuncAttributeMaxDynamicSharedMemorySize, LDS_BYTES) != hipSuccess) { fprintf(stderr, "kernel_launch: hipFuncSetAttribute failed\n"); grid = -1; return; }
        if (hipOccupancyMaxActiveBlocksPerMultiprocessor(&per_cu, (const void*)mk_fwd, NWAVES * 64, LDS_BYTES) != hipSuccess || per_cu < 1)
            fprintf(stderr, "kernel_launch: occupancy query reports %d\n", per_cu);
        (void)hipGetLastError();
        grid = cus;
    }
    if (grid <= 0) return;
    hipMemsetAsync((unsigned char*)d_ws + WS_CTL, 0, CTL_ZERO_BYTES, stream);
    KArgs a{};
    for (int i = 0; i < 26; ++i) a.in[i] = (const float*)d_in[i];
    a.out = (float*)d_out; a.ws = (unsigned char*)d_ws;
#if ONE_LAUNCH
    a.lo = 0; a.hi = N_STEPS;
    hipLaunchKernelGGL(mk_fwd, dim3(grid), dim3(NWAVES * 64), LDS_BYTES, stream, a);
#else
    for (int s = 0; s < N_STEPS; ++s) { a.lo = s; a.hi = s + 1; hipLaunchKernelGGL(mk_fwd, dim3(grid), dim3(NWAVES * 64), LDS_BYTES, stream, a); }
#endif
}
```
